# Optimizing an MI355X kernel written in HIP

```python
import math
import jax, jax.numpy as jnp
from jax import lax
import numpy as np

D_MODEL = 1024
BATCH = 2
SEQ = 8192
DEPTH = 2
DEC_BATCH = 8
DEC_SEQ = 16
PAST_LEN = 4096

CHUNK = 64
N_ATTN_LAYERS = (DEPTH + 1) // 2
N_SSM_LAYERS = DEPTH // 2
EPS = 1e-6
F32 = jnp.float32

A_HEADS = 8
A_KV_HEADS = 2
A_GROUP = A_HEADS // A_KV_HEADS
HEAD_DIM = 64
A_WIDTH = A_HEADS * HEAD_DIM
KV_WIDTH = A_KV_HEADS * HEAD_DIM
WINDOW = 128
BAND_CHUNKS = WINDOW // CHUNK
ROPE_DIM = HEAD_DIM // 4
ROPE_THETA = 500000.0
ATTN_SCALE = HEAD_DIM ** -0.5
WIN_CACHE = min(WINDOW, PAST_LEN)
WIN_PROMPT = min(WINDOW, SEQ)

B_WIDTH = D_MODEL // 2
B_CONV = 3
AB_IN = A_WIDTH + 2 * KV_WIDTH + 3 * B_WIDTH
AB_OUT_IN = A_WIDTH + B_WIDTH

SSM_INNER = 2 * D_MODEL
SSM_HEADDIM = 64
SSM_HEADS = SSM_INNER // SSM_HEADDIM
SSM_GROUPS = 4
SSM_HPG = SSM_HEADS // SSM_GROUPS
SSM_STATE = 128
SSM_CONV = 4
SSM_GN = SSM_GROUPS * SSM_STATE
SSM_CONV_CH = SSM_INNER + 2 * SSM_GN
SSM_IN = 2 * SSM_INNER + 2 * SSM_GN + SSM_HEADS

D_FF = -(-8 * D_MODEL // (3 * 256)) * 256

kernel_name = 'hybrid_chunk_streaming_encoder_step'


def rmsnorm(x, g):
    xf = x.astype(F32)
    xf = xf * lax.rsqrt(jnp.mean(xf * xf, axis=-1, keepdims=True) + EPS)
    return (xf * g.astype(F32)).astype(x.dtype)


def rope_partial(x, pos):
    half = ROPE_DIM // 2
    inv_freq = jnp.power(ROPE_THETA, -jnp.arange(half, dtype=F32) / half)
    ang = pos[:, None] * inv_freq[None, :]
    cos = jnp.cos(ang)[:, None, :].astype(x.dtype)
    sin = jnp.sin(ang)[:, None, :].astype(x.dtype)
    x1 = x[..., :half]
    x2 = x[..., half:ROPE_DIM]
    return jnp.concatenate([x1 * cos - x2 * sin, x2 * cos + x1 * sin, x[..., ROPE_DIM:]], axis=-1)


def sink_attention(q, k, v, sinks, mask):
    s = jnp.einsum('...qkgd,...skd->...kgqs', q, k).astype(F32) * ATTN_SCALE
    if mask is not None:
        s = jnp.where(mask, s, -jnp.inf)
    sink = sinks.astype(F32).reshape(A_KV_HEADS, A_GROUP, 1, 1)
    m = jnp.maximum(jnp.max(s, axis=-1, keepdims=True), sink)
    p = jnp.exp(s - m)
    p = p / (jnp.sum(p, axis=-1, keepdims=True) + jnp.exp(sink - m))
    return jnp.einsum('...kgqs,...skd->...qkgd', p.astype(v.dtype), v)


def band_attention(q, k, v, sinks):
    b, L = q.shape[0], q.shape[1]
    nc = L // CHUNK
    nb = BAND_CHUNKS + 1
    qb = q.reshape(b, nc, CHUNK, A_KV_HEADS, A_GROUP, HEAD_DIM)

    def bands(t):
        tp = jnp.pad(t, ((0, 0), (BAND_CHUNKS * CHUNK, 0), (0, 0), (0, 0)))
        tp = tp.reshape(b, nc + BAND_CHUNKS, CHUNK, A_KV_HEADS, HEAD_DIM)
        return jnp.concatenate([tp[:, j:j + nc] for j in range(nb)], axis=2)

    key_chunk = jnp.arange(nc)[:, None] - BAND_CHUNKS + jnp.arange(nb * CHUNK)[None, :] // CHUNK
    mask = (key_chunk >= 0)[None, :, None, None, None, :]
    o = sink_attention(qb, bands(k), bands(v), sinks, mask)
    return o.reshape(b, L, A_WIDTH)


def causal_dwconv(u, hist, w):
    width = w.shape[0]
    L = u.shape[1]
    up = jnp.concatenate([hist.astype(u.dtype), u], axis=1)
    y = up[:, 0:L] * w[0]
    for j in range(1, width):
        y = y + up[:, j:j + L] * w[j]
    return y, up[:, L:]


def mixer_attn_conv(h, pos, sconv_hist, kv_cache, w_in, w_out, sinks, conv_w):
    b, L, _ = h.shape
    p = h @ w_in
    o1 = A_WIDTH
    o2 = o1 + KV_WIDTH
    o3 = o2 + KV_WIDTH
    o4 = o3 + B_WIDTH
    o5 = o4 + B_WIDTH
    q = rope_partial(p[..., :o1].reshape(b, L, A_HEADS, HEAD_DIM), pos)
    k = rope_partial(p[..., o1:o2].reshape(b, L, A_KV_HEADS, HEAD_DIM), pos)
    v = p[..., o2:o3].reshape(b, L, A_KV_HEADS, HEAD_DIM)
    gate_b = p[..., o3:o4]
    gate_c = p[..., o4:o5]
    hx = p[..., o5:]
    qg = q.reshape(b, L, A_KV_HEADS, A_GROUP, HEAD_DIM)
    if kv_cache is None:
        attn = band_attention(qg, k, v, sinks)
        new_k = k[:, L - WIN_PROMPT:]
        new_v = v[:, L - WIN_PROMPT:]
    else:
        cache_k, cache_v = kv_cache
        k_all = jnp.concatenate([cache_k.astype(k.dtype), k], axis=1)
        v_all = jnp.concatenate([cache_v.astype(v.dtype), v], axis=1)
        attn = sink_attention(qg, k_all, v_all, sinks, None).reshape(b, L, A_WIDTH)
        new_k = k
        new_v = v
    conv_y, new_hist = causal_dwconv(gate_c * hx, sconv_hist, conv_w)
    out = jnp.concatenate([attn, gate_b * conv_y], axis=-1) @ w_out
    return out, new_k, new_v, new_hist


def ssd_scan(x, dt, a, bm, cm, h0):
    b, L = x.shape[0], x.shape[1]
    lc = min(CHUNK, L)
    nc = L // lc
    x = x.reshape(b, nc, lc, SSM_GROUPS, SSM_HPG, SSM_HEADDIM)
    dt = dt.reshape(b, nc, lc, SSM_GROUPS, SSM_HPG)
    bm = bm.reshape(b, nc, lc, SSM_GROUPS, SSM_STATE)
    cm = cm.reshape(b, nc, lc, SSM_GROUPS, SSM_STATE)
    h0 = h0.reshape(b, SSM_GROUPS, SSM_HPG, SSM_HEADDIM, SSM_STATE)
    acum = jnp.cumsum(dt * a.reshape(SSM_GROUPS, SSM_HPG), axis=2)
    causal = jnp.tril(jnp.ones((lc, lc), dtype=bool))[None, None, :, :, None, None]
    seg = acum[:, :, :, None] - acum[:, :, None, :]
    decay = jnp.exp(jnp.where(causal, seg, -jnp.inf))
    cb = jnp.einsum('bclgn,bcsgn->bclsg', cm, bm)
    wgt = cb[..., None] * decay * dt[:, :, None]
    y_diag = jnp.einsum('bclsgr,bcsgrp->bclgrp', wgt, x)
    decay_end = jnp.exp(acum[:, :, -1:] - acum) * dt
    states = jnp.einsum('bclgn,bclgr,bclgrp->bcgrpn', bm, decay_end, x)
    chunk_decay = jnp.exp(acum[:, :, -1])

    def step(hc, inp):
        dec, st = inp
        return hc * dec[..., None, None] + st, hc

    h_last, h_prev = lax.scan(step, h0, (jnp.moveaxis(chunk_decay, 1, 0), jnp.moveaxis(states, 1, 0)))
    h_prev = jnp.moveaxis(h_prev, 0, 1)
    y_off = jnp.einsum('bclgn,bcgrpn->bclgrp', cm, h_prev) * jnp.exp(acum)[..., None]
    y = (y_diag + y_off).reshape(b, L, SSM_HEADS, SSM_HEADDIM)
    return y, h_last.reshape(b, SSM_HEADS, SSM_HEADDIM, SSM_STATE)


def mixer_ssd(h, conv_hist, ssm_state, w_in, conv_w, conv_b, dt_bias, a_log, d_skip, norm_g, w_out):
    b, L, _ = h.shape
    p = h @ w_in
    z = p[..., :SSM_INNER]
    xbc = p[..., SSM_INNER:SSM_INNER + SSM_CONV_CH]
    dt_raw = p[..., SSM_INNER + SSM_CONV_CH:]
    xbc, new_conv = causal_dwconv(xbc, conv_hist, conv_w)
    xbc = jax.nn.silu(xbc + conv_b)
    xs = xbc[..., :SSM_INNER].reshape(b, L, SSM_HEADS, SSM_HEADDIM).astype(F32)
    bm = xbc[..., SSM_INNER:SSM_INNER + SSM_GN].reshape(b, L, SSM_GROUPS, SSM_STATE).astype(F32)
    cm = xbc[..., SSM_INNER + SSM_GN:].reshape(b, L, SSM_GROUPS, SSM_STATE).astype(F32)
    dt = jax.nn.softplus(dt_raw.astype(F32) + dt_bias.astype(F32))
    a = -jnp.exp(a_log.astype(F32))
    y, new_state = ssd_scan(xs, dt, a, bm, cm, ssm_state.astype(F32))
    y = y + d_skip.astype(F32)[:, None] * xs
    g = y.reshape(b, L, SSM_INNER) * jax.nn.silu(z.astype(F32))
    g = g.reshape(b, L, SSM_GROUPS, SSM_INNER // SSM_GROUPS)
    g = g * lax.rsqrt(jnp.mean(g * g, axis=-1, keepdims=True) + EPS)
    g = g.reshape(b, L, SSM_INNER) * norm_g.astype(F32)
    out = g.astype(h.dtype) @ w_out
    return out, new_conv, new_state.astype(ssm_state.dtype)


def swiglu(h, w_gate, w_up, w_down):
    return (jax.nn.silu(h @ w_gate) * (h @ w_up)) @ w_down


def setup_inputs(seed: int = 0) -> dict:
    key = jax.random.key(seed)
    ks = jax.random.split(key, 26)
    NA, NS = N_ATTN_LAYERS, N_SSM_LAYERS

    def nrm(k, shape, scale):
        return jax.random.normal(k, shape, F32) * scale

    dt0 = jnp.exp(jax.random.uniform(ks[20], (NS, SSM_HEADS), F32, math.log(1e-3), math.log(1e-1)))
    return {
        'x_prompt': nrm(ks[0], (BATCH, SEQ, D_MODEL), 1.0),
        'x_sample': nrm(ks[1], (DEC_BATCH, DEC_SEQ, D_MODEL), 1.0),
        'cache_attn_k': nrm(ks[2], (NA, DEC_BATCH, WIN_CACHE, A_KV_HEADS, HEAD_DIM), 1.0),
        'cache_attn_v': nrm(ks[3], (NA, DEC_BATCH, WIN_CACHE, A_KV_HEADS, HEAD_DIM), 1.0),
        'state_sconv': nrm(ks[4], (NA, DEC_BATCH, B_CONV - 1, B_WIDTH), 1.0),
        'state_ssm_conv': nrm(ks[5], (NS, DEC_BATCH, SSM_CONV - 1, SSM_CONV_CH), 1.0),
        'state_ssm': nrm(ks[6], (NS, DEC_BATCH, SSM_HEADS, SSM_HEADDIM, SSM_STATE), 0.1),
        'norm_g': 1.0 + nrm(ks[7], (DEPTH, 4, D_MODEL), 0.05),
        'ab_w_in': nrm(ks[8], (NA, D_MODEL, AB_IN), D_MODEL ** -0.5),
        'ab_w_out': nrm(ks[9], (NA, AB_OUT_IN, D_MODEL), AB_OUT_IN ** -0.5),
        'attn_sinks': nrm(ks[10], (NA, A_HEADS), 0.5),
        'sconv_w': nrm(ks[11], (NA, B_CONV, B_WIDTH), B_CONV ** -0.5),
        'ssm_w_in': nrm(ks[12], (NS, D_MODEL, SSM_IN), D_MODEL ** -0.5),
        'ssm_conv_w': nrm(ks[13], (NS, SSM_CONV, SSM_CONV_CH), SSM_CONV ** -0.5),
        'ssm_conv_b': nrm(ks[14], (NS, SSM_CONV_CH), 0.02),
        'ssm_dt_bias': dt0 + jnp.log(-jnp.expm1(-dt0)),
        'ssm_a_log': jnp.log(jax.random.uniform(ks[15], (NS, SSM_HEADS), F32, 1.0, 16.0)),
        'ssm_d': 1.0 + nrm(ks[16], (NS, SSM_HEADS), 0.1),
        'ssm_norm_g': 1.0 + nrm(ks[17], (NS, SSM_INNER), 0.05),
        'ssm_w_out': nrm(ks[18], (NS, SSM_INNER, D_MODEL), SSM_INNER ** -0.5),
        'ffn_w_gate': nrm(ks[19], (DEPTH, D_MODEL, D_FF), D_MODEL ** -0.5),
        'ffn_w_up': nrm(ks[21], (DEPTH, D_MODEL, D_FF), D_MODEL ** -0.5),
        'ffn_w_down': nrm(ks[22], (DEPTH, D_FF, D_MODEL), D_FF ** -0.5),
    }


def reference(x_prompt, x_sample, cache_attn_k, cache_attn_v, state_sconv, state_ssm_conv, state_ssm,
              norm_g, ab_w_in, ab_w_out, attn_sinks, sconv_w, ssm_w_in, ssm_conv_w, ssm_conv_b,
              ssm_dt_bias, ssm_a_log, ssm_d, ssm_norm_g, ssm_w_out, ffn_w_gate, ffn_w_up, ffn_w_down):
    pos_p = jnp.arange(SEQ, dtype=F32)
    pos_s = PAST_LEN + jnp.arange(DEC_SEQ, dtype=F32)
    xp, xs = x_prompt, x_sample
    kp_l, vp_l, scp_l, ks_l, vs_l, scs_l = [], [], [], [], [], []
    ccp_l, ssp_l, ccs_l, sss_l = [], [], [], []
    for layer in range(DEPTH):
        g = norm_g[layer]
        i = layer // 2
        hp = rmsnorm(xp, g[0])
        hs = rmsnorm(xs, g[0])
        if layer % 2 == 0:
            wts = (ab_w_in[i], ab_w_out[i], attn_sinks[i], sconv_w[i])
            zero_hist = jnp.zeros((BATCH, B_CONV - 1, B_WIDTH), xp.dtype)
            mp, nkp, nvp, nscp = mixer_attn_conv(hp, pos_p, zero_hist, None, *wts)
            ms, nks, nvs, nscs = mixer_attn_conv(hs, pos_s, state_sconv[i],
                                                 (cache_attn_k[i], cache_attn_v[i]), *wts)
            kp_l.append(nkp)
            vp_l.append(nvp)
            scp_l.append(nscp)
            ks_l.append(nks)
            vs_l.append(nvs)
            scs_l.append(nscs)
        else:
            wts = (ssm_w_in[i], ssm_conv_w[i], ssm_conv_b[i], ssm_dt_bias[i], ssm_a_log[i],
                   ssm_d[i], ssm_norm_g[i], ssm_w_out[i])
            zero_conv = jnp.zeros((BATCH, SSM_CONV - 1, SSM_CONV_CH), xp.dtype)
            zero_state = jnp.zeros((BATCH, SSM_HEADS, SSM_HEADDIM, SSM_STATE), state_ssm.dtype)
            mp, nccp, nssp = mixer_ssd(hp, zero_conv, zero_state, *wts)
            ms, nccs, nsss = mixer_ssd(hs, state_ssm_conv[i], state_ssm[i], *wts)
            ccp_l.append(nccp)
            ssp_l.append(nssp)
            ccs_l.append(nccs)
            sss_l.append(nsss)
        xp = xp + rmsnorm(mp, g[1])
        xs = xs + rmsnorm(ms, g[1])
        fw = (ffn_w_gate[layer], ffn_w_up[layer], ffn_w_down[layer])
        xp = xp + rmsnorm(swiglu(rmsnorm(xp, g[2]), *fw), g[3])
        xs = xs + rmsnorm(swiglu(rmsnorm(xs, g[2]), *fw), g[3])
    return (xp, xs,
            jnp.stack(kp_l), jnp.stack(vp_l), jnp.stack(scp_l), jnp.stack(ccp_l), jnp.stack(ssp_l),
            jnp.stack(ks_l), jnp.stack(vs_l), jnp.stack(scs_l), jnp.stack(ccs_l), jnp.stack(sss_l))
```

```cpp
#include <hip/hip_runtime.h>
#include <hip/hip_cooperative_groups.h>
#include <cstdio>
#include <cstdint>
namespace cg = cooperative_groups;
#define MK_ONE_LAUNCH 1
namespace pg8 {
#define PG8_LAS __attribute__((address_space(3)))
typedef unsigned short bf16_t;
typedef short bf16x8 __attribute__((ext_vector_type(8)));
typedef float f32x4 __attribute__((ext_vector_type(4)));
typedef unsigned u32x4 __attribute__((ext_vector_type(4)));
constexpr int BM = 256, BK = 64, HALF = 128, HTB = HALF * BK * 2  , STAGE_BYTES = 8 * HTB, NXCD = 8, WGM = 8;

__host__ __device__ __forceinline__ int lds_byte(int r, int c) { const int st = (r >> 4) * 2 + (c >> 5), rr = r & 15, cc = c & 31, ob = rr * 64 + cc * 2; return st * 1024 + (ob ^ (((ob >> 9) & 1) << 5)); }
__host__ __device__ __forceinline__ void stage_rc(int b, int& R, int& C) { const int st = b / 1024, sb = b % 1024, swz = sb ^ (((sb >> 9) & 1) << 5); R = (st >> 1) * 16 + swz / 64; C = (st & 1) * 32 + (swz % 64) / 2; }
__host__ __device__ __forceinline__ int perm32(int rho) { const int n = rho >> 4, i = rho & 15; return 8 * (i >> 2) + 4 * n + (i & 3); }

struct Unit { int pm, pn; };
struct Gemm { const bf16_t* A; const bf16_t* Bt; int M, N, K; };

struct StaticOrder {
    int nM, nN, nwg, G, c;
    __host__ __device__ void init(int M, int N, int G_, int c_) { nM = M / BM; nN = N / BM; nwg = nM * nN; G = G_; c = c_; }
    __host__ __device__ bool next(int i, Unit& u) const {
        const long L = (long)i * G + c; if (L >= nwg) return false;
        int wgid = (int)L; { const int q = nwg / NXCD, r = nwg % NXCD, xcd = wgid % NXCD, off = wgid / NXCD; wgid = (xcd < r ? xcd * (q + 1) : r * (q + 1) + (xcd - r) * q) + off; }
        const int nig = WGM * nN, gid = wgid / nig, fm = gid * WGM, gsz = (nM - fm) < WGM ? (nM - fm) : WGM;
        u.pm = fm + ((wgid % nig) % gsz); u.pn = (wgid % nig) / gsz; return true;
    }
    __device__ __forceinline__ void a_ready(const Unit&) const {}
    __device__ __forceinline__ void done(const Unit&) const {}
};

__device__ __forceinline__ unsigned cvt_pk_bf16(float lo, float hi) { unsigned r; asm volatile("v_cvt_pk_bf16_f32 %0, %1, %2" : "=v"(r) : "v"(lo), "v"(hi)); return r; }
__device__ __forceinline__ float silu_f(float v) { return v * __builtin_amdgcn_rcpf(1.0f + __expf(-v)); }
struct EpiSplit {
    static constexpr bool PERM = true, AFTER_DRAIN = false;
    bf16_t* O0; int ld0; int c1; bf16_t* O1; int ld1; int c2; float* O2; int ld2; bf16_t* halo;
    __device__ __forceinline__ void operator()(const f32x4 (&acc)[2][2][4][2], const Unit& u, int wr, int wc, int fr, int fq) const {
        const int row0 = u.pm * BM + wr * 64 + fr; const int colt = u.pn * BM;
        if (colt >= c2) {
            if (wc == 0) {
#pragma unroll
                for (int ai = 0; ai < 2; ++ai)
#pragma unroll
                    for (int m = 0; m < 4; ++m) { float* rp = O2 + (size_t)(row0 + ai * HALF + m * 16) * ld2 + 8 * fq; *(f32x4*)rp = acc[ai][0][m][0]; *(f32x4*)(rp + 4) = acc[ai][0][m][1]; }
            }
            return;
        }
        bf16_t* base; int ld, cb; bool hal = false;
        if (colt < c1) { base = O0; ld = ld0; cb = colt; } else { base = O1; ld = ld1; cb = colt - c1; hal = (halo != nullptr); }
        const int col0 = cb + wc * 32 + 8 * fq;
#pragma unroll
        for (int ai = 0; ai < 2; ++ai)
#pragma unroll
            for (int m = 0; m < 4; ++m) { const int r = row0 + ai * HALF + m * 16; bf16_t* rowp = base + (size_t)r * ld + col0;
#pragma unroll
                for (int bj = 0; bj < 2; ++bj) { const f32x4 v0 = acc[ai][bj][m][0], v1 = acc[ai][bj][m][1];
                    u32x4 w; w.x = cvt_pk_bf16(v0[0], v0[1]); w.y = cvt_pk_bf16(v0[2], v0[3]); w.z = cvt_pk_bf16(v1[0], v1[1]); w.w = cvt_pk_bf16(v1[2], v1[3]);
                    *(u32x4*)(rowp + bj * HALF) = w;
                    if (m == 3 && hal && fr >= 13) *(u32x4*)(halo + (size_t)((r >> 6) * 3 + (fr - 13)) * ld1 + col0 + bj * HALF) = w; } }
    }
};
struct EpiSwiGLU {
    static constexpr bool PERM = false, AFTER_DRAIN = false;
    bf16_t* H; int ldh;
    __device__ __forceinline__ void operator()(const f32x4 (&acc)[2][2][4][2], const Unit& u, int wr, int wc, int fr, int fq) const {
        const int row0 = u.pm * BM + wr * 64 + fr; const int hcol0 = (u.pn * BM + wc * 32) / 2 + 4 * fq;
        typedef unsigned u32x2v __attribute__((ext_vector_type(2)));
#pragma unroll
        for (int ai = 0; ai < 2; ++ai)
#pragma unroll
            for (int m = 0; m < 4; ++m) { bf16_t* rowp = H + (size_t)(row0 + ai * HALF + m * 16) * ldh + hcol0;
#pragma unroll
                for (int bj = 0; bj < 2; ++bj) { const f32x4 g = acc[ai][bj][m][0], up = acc[ai][bj][m][1];
                    u32x2v w; w.x = cvt_pk_bf16(silu_f(g[0]) * up[0], silu_f(g[1]) * up[1]); w.y = cvt_pk_bf16(silu_f(g[2]) * up[2], silu_f(g[3]) * up[3]);
                    *(u32x2v*)(rowp + bj * 64) = w; } }
    }
};
template <class Epi, class Sched, bool ALIGN_EPI = false, bool SP2 = false>
__device__ __forceinline__ void gemm_phase(PG8_LAS unsigned char* lds, const Gemm g, const Sched& S, const Epi& E) {
    const int tid = threadIdx.x, wid = __builtin_amdgcn_readfirstlane(tid >> 6), lane = tid & 63, wr = wid >> 2, wc = wid & 3, fr = lane & 15, fq = lane >> 4;
    const int K = g.K, nt = K / BK;
    unsigned voffA[2], voffB[2];
#pragma unroll
    for (int i = 0; i < 2; ++i) { int R, C; stage_rc(tid * 16 + i * 8192, R, C); const int Rb = Epi::PERM ? ((R & ~31) + perm32(R & 31)) : R;
        voffA[i] = (unsigned)(R * K + C) * 2u; voffB[i] = (unsigned)(Rb * K + C) * 2u; }
    const size_t kstep = (size_t)(BK * 2);
    const size_t hstep = (size_t)HALF * K * 2;
    const size_t tstep = 2 * hstep;
    const unsigned ldsw = (unsigned)wid * 1024u;
    const int aoff = lds_byte(wr * 64 + fr, fq * 8), boff = lds_byte(wc * 32 + fr, fq * 8);
#define PG8_SA(b, h) (((b) * 2 + (h)) * HTB)
#define PG8_SB(b, h) ((4 + (b) * 2 + (h)) * HTB)
#define PG8_STAGE(bufoff, gbase, voff) do { _Pragma("unroll") for (int _i = 0; _i < 2; ++_i) \
        __builtin_amdgcn_global_load_lds((const unsigned*)((const char*)(gbase) + (voff)[_i]), (PG8_LAS unsigned*)(lds + (bufoff) + ldsw + _i * 8192), 16, 0, 0); } while (0)
#define PG8_LDA(dst, b, h) do { _Pragma("unroll") for (int m = 0; m < 4; ++m) _Pragma("unroll") for (int k = 0; k < 2; ++k) dst[m][k] = *(const PG8_LAS bf16x8*)(lds + PG8_SA(b, h) + aoff + m * 2048 + k * 1024); } while (0)
#define PG8_LDB(dst, b, h) do { _Pragma("unroll") for (int n = 0; n < 2; ++n) _Pragma("unroll") for (int k = 0; k < 2; ++k) dst[n][k] = *(const PG8_LAS bf16x8*)(lds + PG8_SB(b, h) + boff + n * 2048 + k * 1024); } while (0)
#define PG8_MMA(ai, bj, At, Bt) do { __builtin_amdgcn_s_setprio(1); _Pragma("unroll") for (int m = 0; m < 4; ++m) _Pragma("unroll") for (int n = 0; n < 2; ++n) _Pragma("unroll") for (int k = 0; k < 2; ++k) \
        acc[ai][bj][m][n] = __builtin_amdgcn_mfma_f32_16x16x32_bf16(Bt[n][k], At[m][k], acc[ai][bj][m][n], 0, 0, 0); __builtin_amdgcn_s_setprio(0); } while (0)
#define PG8_WAIT_V(n) asm volatile("s_waitcnt vmcnt(" #n ")" ::: "memory")
#define PG8_WAIT_L(n) asm volatile("s_waitcnt lgkmcnt(" #n ")" ::: "memory")
#define PG8_BAR __builtin_amdgcn_s_barrier()
#define PG8_SCHED __builtin_amdgcn_sched_barrier(0)
    Unit cur, nxt; int ui = 0;
    if (!S.next(0, cur)) return;
    f32x4 acc[2][2][4][2];
#pragma unroll
    for (int a = 0; a < 2; ++a)
#pragma unroll
        for (int b = 0; b < 2; ++b)
#pragma unroll
            for (int m = 0; m < 4; ++m)
#pragma unroll
                for (int n = 0; n < 2; ++n) acc[a][b][m][n] = (f32x4){0.f, 0.f, 0.f, 0.f};
    bf16x8 At[4][2], B0[2][2], B1[2][2];
    const char* cA = (const char*)g.A + (size_t)cur.pm * tstep; const char* cB = (const char*)g.Bt + (size_t)cur.pn * tstep;
    S.a_ready(cur);
    if constexpr (SP2) {
        PG8_STAGE(PG8_SB(0, 0), cB, voffB); PG8_STAGE(PG8_SB(0, 1), cB + hstep, voffB); PG8_STAGE(PG8_SA(0, 0), cA, voffA); PG8_STAGE(PG8_SA(0, 1), cA + hstep, voffA);
        if (wr == 1) PG8_BAR;
        PG8_WAIT_V(2); PG8_BAR;
        PG8_STAGE(PG8_SB(1, 0), cB + kstep, voffB); PG8_STAGE(PG8_SA(1, 0), cA + kstep, voffA); PG8_STAGE(PG8_SB(1, 1), cB + hstep + kstep, voffB);
        PG8_WAIT_V(6); PG8_BAR;
    } else {
        PG8_STAGE(PG8_SB(0, 0), cB, voffB); PG8_STAGE(PG8_SA(0, 0), cA, voffA); PG8_STAGE(PG8_SB(0, 1), cB + hstep, voffB); PG8_STAGE(PG8_SA(0, 1), cA + hstep, voffA);
        if (wr == 1) PG8_BAR;
        PG8_WAIT_V(4); PG8_BAR;
        PG8_STAGE(PG8_SB(1, 0), cB + kstep, voffB); PG8_STAGE(PG8_SA(1, 0), cA + kstep, voffA); PG8_STAGE(PG8_SB(1, 1), cB + hstep + kstep, voffB);
        PG8_WAIT_V(6); PG8_BAR;
    }
    for (;;) {
        const bool has_next = S.next(ui + 1, nxt);
        const char* nA = has_next ? (const char*)g.A + (size_t)nxt.pm * tstep : cA; const char* nB = has_next ? (const char*)g.Bt + (size_t)nxt.pn * tstep : cB;
        for (int t = 0; t < nt; t += 2) {
            const bool last = (t == nt - 2);
            const char* a1 = cA + (size_t)(t + 1) * kstep;
            const char* a2 = last ? nA : cA + (size_t)(t + 2) * kstep; const char* b2 = last ? nB : cB + (size_t)(t + 2) * kstep;
            const char* a3 = a2 + kstep; const char* b3 = b2 + kstep;
            if (last && has_next) S.a_ready(nxt);
            if constexpr (SP2) {
            PG8_LDB(B0, 0, 0); PG8_LDB(B1, 0, 1); PG8_SCHED; PG8_LDA(At, 0, 0); PG8_STAGE(PG8_SA(1, 1), a1 + hstep, voffA);
            PG8_WAIT_V(8); PG8_WAIT_L(0); PG8_BAR; PG8_MMA(0, 0, At, B0); PG8_MMA(0, 1, At, B1); PG8_BAR; PG8_SCHED;
            PG8_LDA(At, 0, 1); PG8_STAGE(PG8_SB(0, 0), b2, voffB); PG8_STAGE(PG8_SB(0, 1), b2 + hstep, voffB); PG8_STAGE(PG8_SA(0, 0), a2, voffA);
            PG8_WAIT_V(8); PG8_WAIT_L(0); PG8_BAR; PG8_MMA(1, 0, At, B0); PG8_MMA(1, 1, At, B1); PG8_BAR; PG8_SCHED;
            PG8_LDB(B0, 1, 0); PG8_LDB(B1, 1, 1); PG8_SCHED; PG8_LDA(At, 1, 0); PG8_STAGE(PG8_SA(0, 1), a2 + hstep, voffA);
            PG8_WAIT_V(8); PG8_WAIT_L(0); PG8_BAR; PG8_MMA(0, 0, At, B0); PG8_MMA(0, 1, At, B1); PG8_BAR; PG8_SCHED;
            PG8_LDA(At, 1, 1); PG8_STAGE(PG8_SB(1, 0), b3, voffB); PG8_STAGE(PG8_SB(1, 1), b3 + hstep, voffB); PG8_STAGE(PG8_SA(1, 0), a3, voffA);
            PG8_WAIT_V(8); PG8_WAIT_L(0); PG8_BAR; PG8_MMA(1, 0, At, B0); PG8_MMA(1, 1, At, B1); PG8_BAR; PG8_SCHED;
            } else {
            PG8_LDB(B0, 0, 0); PG8_SCHED; PG8_LDA(At, 0, 0); PG8_STAGE(PG8_SA(1, 1), a1 + hstep, voffA);
            PG8_WAIT_L(8); PG8_BAR; PG8_WAIT_L(0); PG8_MMA(0, 0, At, B0); PG8_BAR; PG8_SCHED;
            PG8_LDB(B1, 0, 1); PG8_STAGE(PG8_SB(0, 0), b2, voffB);
            PG8_BAR; PG8_WAIT_L(0); PG8_MMA(0, 1, At, B1); PG8_BAR;
            PG8_LDA(At, 0, 1); PG8_STAGE(PG8_SA(0, 0), a2, voffA);
            PG8_BAR; PG8_WAIT_L(0); PG8_MMA(1, 0, At, B0); PG8_BAR; PG8_SCHED;
            PG8_STAGE(PG8_SB(0, 1), b2 + hstep, voffB);
            PG8_WAIT_V(6); PG8_BAR; PG8_MMA(1, 1, At, B1); PG8_BAR;
            PG8_LDB(B0, 1, 0); PG8_SCHED; PG8_LDA(At, 1, 0); PG8_STAGE(PG8_SA(0, 1), a2 + hstep, voffA);
            PG8_WAIT_L(8); PG8_BAR; PG8_WAIT_L(0); PG8_MMA(0, 0, At, B0); PG8_BAR; PG8_SCHED;
            PG8_LDB(B1, 1, 1); PG8_STAGE(PG8_SB(1, 0), b3, voffB);
            PG8_BAR; PG8_WAIT_L(0); PG8_MMA(0, 1, At, B1); PG8_BAR;
            PG8_LDA(At, 1, 1); PG8_STAGE(PG8_SA(1, 0), a3, voffA);
            PG8_BAR; PG8_WAIT_L(0); PG8_MMA(1, 0, At, B0); PG8_BAR; PG8_SCHED;
            PG8_STAGE(PG8_SB(1, 1), b3 + hstep, voffB);
            PG8_WAIT_V(6); PG8_BAR; PG8_MMA(1, 1, At, B1); PG8_BAR;
            }
        }
        if constexpr (ALIGN_EPI) { if (wr == 0) PG8_BAR; }
        if constexpr (!Epi::AFTER_DRAIN) { E(acc, cur, wr, wc, fr, fq); S.done(cur); }
        if (!has_next) break;
#pragma unroll
        for (int a = 0; a < 2; ++a)
#pragma unroll
            for (int b = 0; b < 2; ++b)
#pragma unroll
                for (int m = 0; m < 4; ++m)
#pragma unroll
                    for (int n = 0; n < 2; ++n) acc[a][b][m][n] = (f32x4){0.f, 0.f, 0.f, 0.f};
        cur = nxt; cA = nA; cB = nB; ++ui;
        if constexpr (ALIGN_EPI) { if (wr == 1) PG8_BAR; }
    }
    PG8_WAIT_V(0);
    if constexpr (!ALIGN_EPI) { if (wr == 0) PG8_BAR; }
    PG8_BAR;
    if constexpr (Epi::AFTER_DRAIN) { E.fused(acc, cur, wr, wc, fr, fq, lds, wid, lane); S.done(cur); }
#undef PG8_SA
#undef PG8_SB
#undef PG8_STAGE
#undef PG8_LDA
#undef PG8_LDB
#undef PG8_MMA
#undef PG8_WAIT_V
#undef PG8_WAIT_L
#undef PG8_BAR
#undef PG8_SCHED
}
}

#define LAS __attribute__((address_space(3)))
typedef unsigned short bf16;
typedef pg8::f32x4 f32x4;
typedef pg8::bf16x8 bf16x8;
typedef pg8::u32x4 u32x4;
typedef unsigned u32x2 __attribute__((ext_vector_type(2)));
typedef float f32x2 __attribute__((ext_vector_type(2)));

constexpr int NWAVES = 8, NTHR = 512;
constexpr int DM = 1024, MPR = 16384, MV = 16512, MPAD = 16640, SEQ = 8192;
constexpr int AB_IN = 2304, DFF = 2816, SSM_INP = 5376, SSM_INV = 5152, XBCW = 3072, ZW = 2048;
constexpr float EPS = 1e-6f;
constexpr size_t MiB = 1u << 20;
constexpr size_t WS_ROPE = 0;
constexpr size_t WS_W_ABIN = 1 * MiB, WS_W_ABOUT = WS_W_ABIN + 9 * MiB / 2, WS_W_UP0 = WS_W_ABOUT + 2 * MiB, WS_W_DN0 = WS_W_UP0 + 11 * MiB;
constexpr size_t WS_HALO = 1 * MiB, WS_DT = 6 * MiB, WS_SEG = 9 * MiB, WS_SEGD = 16 * MiB;
constexpr size_t WS_W_SSMIN = 24 * MiB, WS_W_SSMOUT = WS_W_SSMIN + 21 * MiB / 2, WS_W_UP1 = WS_W_SSMOUT + 4 * MiB, WS_W_DN1 = WS_W_UP1 + 11 * MiB;
constexpr size_t WS_XN = 55 * MiB;
constexpr size_t WS_P0 = 88 * MiB, WS_CAT = 162 * MiB, WS_MIX = 195 * MiB, WS_H = 88 * MiB, WS_Z = 88 * MiB, WS_XBC = 153 * MiB, WS_END = 256 * MiB;
static_assert(WS_W_DN0 + (size_t)DM * DFF * 2 <= 24 * MiB && WS_W_DN1 + (size_t)DM * DFF * 2 <= WS_XN && WS_XN + (size_t)MPAD * DM * 2 <= WS_P0, "ws map 1");
static_assert(WS_P0 + (size_t)MPAD * AB_IN * 2 <= WS_CAT && WS_CAT + (size_t)MPAD * DM * 2 <= WS_MIX && WS_MIX + (size_t)MPAD * DM * 2 <= WS_END, "ws map 2");
static_assert(WS_H + (size_t)MPAD * DFF * 2 <= WS_MIX && WS_Z + (size_t)MPAD * ZW * 2 <= WS_XBC && WS_XBC + (size_t)MPAD * XBCW * 2 <= WS_END, "ws map 3");
static_assert(WS_HALO + (size_t)260 * 3 * XBCW * 2 <= WS_DT && WS_DT + (size_t)MPAD * 32 * 4 <= WS_SEG && WS_SEG + (size_t)192 * 8192 * 4 <= WS_SEGD, "ws map 4");
constexpr size_t O_Y = 0, O_KP = 16908288, O_VP = O_KP + 32768, O_SCP = O_VP + 32768, O_CCP = O_SCP + 2048, O_SSP = O_CCP + 18432, O_KS = O_SSP + 524288, O_VS = O_KS + 16384,
                 O_SCS = O_VS + 16384, O_CCS = O_SCS + 8192, O_SSS = O_CCS + 73728, O_END = O_SSS + 2097152;
static_assert(O_END == 19730432, "output size");
constexpr int LDS_BYTES = 147456;

struct Args { const float* in[23]; float* out; unsigned char* ws; int ph_lo, ph_hi; };
enum { I_XP = 0, I_XS, I_CK, I_CV, I_SCONV, I_SSMCONV, I_SSM, I_NG, I_ABIN, I_ABOUT, I_SINK, I_SCW, I_SSMIN, I_SSMCW, I_SSMCB, I_DTB, I_ALOG, I_SSMD, I_SSMNG, I_SSMOUT, I_FG, I_FU, I_FD };

#define LDS_WAIT() asm volatile("s_waitcnt lgkmcnt(0)" ::: "memory")
__device__ __forceinline__ unsigned pk2(float lo, float hi) { return pg8::cvt_pk_bf16(lo, hi); }
__device__ __forceinline__ unsigned short f2bf(float f) { return (unsigned short)(pk2(f, 0.f) & 0xffffu); }
__device__ __forceinline__ float bflo(unsigned w) { return __builtin_bit_cast(float, w << 16); }
__device__ __forceinline__ float bfhi(unsigned w) { return __builtin_bit_cast(float, w & 0xffff0000u); }
__device__ __forceinline__ float bf1(unsigned short h) { return __builtin_bit_cast(float, (unsigned)h << 16); }
__device__ __forceinline__ void unpack8(const u32x4 w, float (&f)[8]) { f[0] = bflo(w.x); f[1] = bfhi(w.x); f[2] = bflo(w.y); f[3] = bfhi(w.y); f[4] = bflo(w.z); f[5] = bfhi(w.z); f[6] = bflo(w.w); f[7] = bfhi(w.w); }
__device__ __forceinline__ u32x4 pack8(const float (&f)[8]) { u32x4 w; w.x = pk2(f[0], f[1]); w.y = pk2(f[2], f[3]); w.z = pk2(f[4], f[5]); w.w = pk2(f[6], f[7]); return w; }
__device__ __forceinline__ float wave_sum(float v) {
#pragma unroll
    for (int o = 1; o < 64; o <<= 1) v += __shfl_xor(v, o);
    return v;
}
__device__ __forceinline__ float silu(float v) { return v * __builtin_amdgcn_rcpf(1.0f + __expf(-v)); }
__device__ __forceinline__ f32x4 mfma16(bf16x8 a, bf16x8 b, f32x4 c) { return __builtin_amdgcn_mfma_f32_16x16x32_bf16(a, b, c, 0, 0, 0); }

__device__ __forceinline__ void transpose_item(const float* W, int K, int N, bf16* WT, int mode, LAS float* scr, int item, int lane) {
    const int nblk = N / 32, kb = item / nblk, nb = item % nblk, k0 = 64 * kb, n0 = 32 * nb;
#pragma unroll 8
    for (int i = 0; i < 32; ++i) { const int kk = 2 * i + (lane >> 5); scr[kk * 33 + (lane & 31)] = W[(size_t)(k0 + kk) * N + n0 + (lane & 31)]; }
    LDS_WAIT(); asm volatile("" ::: "memory");
    const int c = lane & 7;
#pragma unroll
    for (int j = 0; j < 4; ++j) { const int n = (lane >> 3) + 8 * j; const LAS float* s = scr + (8 * c) * 33 + n; const int cn = n0 + n;
        const int drow = (mode == 0) ? cn : (((cn >> 4) << 5) + (cn & 15) + (mode == 2 ? 16 : 0));
        u32x4 o; o.x = pk2(s[0 * 33], s[1 * 33]); o.y = pk2(s[2 * 33], s[3 * 33]); o.z = pk2(s[4 * 33], s[5 * 33]); o.w = pk2(s[6 * 33], s[7 * 33]);
        *(u32x4*)(WT + (size_t)drow * K + k0 + 8 * c) = o; }
    LDS_WAIT(); asm volatile("" ::: "memory");
}
__device__ __forceinline__ void p0_prologue(const Args& a, LAS unsigned char* lds, int G, int bid) {
    const int tid = threadIdx.x, lane = tid & 63, wave = tid >> 6;
    unsigned char* ws = a.ws;
    LAS float* scr = (LAS float*)(lds + wave * 16384);
    const int gw = bid * NWAVES + wave, NGW = G * NWAVES;
    constexpr int I_1 = 16 * 72, I_2 = 16 * 32, I_F = 16 * 88, I_D = 44 * 32, I_5 = 16 * 161, I_6 = 32 * 32;
    constexpr int NITEMS = I_1 + I_2 + 4 * I_F + 2 * I_D + I_5 + I_6;
    for (int it = gw; it < NITEMS; it += NGW) {
        int r = it;
        if (r < I_5) { transpose_item(a.in[I_SSMIN], DM, SSM_INV, (bf16*)(ws + WS_W_SSMIN), 0, scr, r, lane); continue; } r -= I_5;
        if (r < I_1) { transpose_item(a.in[I_ABIN], DM, AB_IN, (bf16*)(ws + WS_W_ABIN), 0, scr, r, lane); continue; } r -= I_1;
        if (r < I_2) { transpose_item(a.in[I_ABOUT], DM, DM, (bf16*)(ws + WS_W_ABOUT), 0, scr, r, lane); continue; } r -= I_2;
        if (r < I_F) { transpose_item(a.in[I_FG], DM, DFF, (bf16*)(ws + WS_W_UP0), 1, scr, r, lane); continue; } r -= I_F;
        if (r < I_F) { transpose_item(a.in[I_FU], DM, DFF, (bf16*)(ws + WS_W_UP0), 2, scr, r, lane); continue; } r -= I_F;
        if (r < I_D) { transpose_item(a.in[I_FD], DFF, DM, (bf16*)(ws + WS_W_DN0), 0, scr, r, lane); continue; } r -= I_D;
        if (r < I_6) { transpose_item(a.in[I_SSMOUT], ZW, DM, (bf16*)(ws + WS_W_SSMOUT), 0, scr, r, lane); continue; } r -= I_6;
        if (r < I_F) { transpose_item(a.in[I_FG] + (size_t)DM * DFF, DM, DFF, (bf16*)(ws + WS_W_UP1), 1, scr, r, lane); continue; } r -= I_F;
        if (r < I_F) { transpose_item(a.in[I_FU] + (size_t)DM * DFF, DM, DFF, (bf16*)(ws + WS_W_UP1), 2, scr, r, lane); continue; } r -= I_F;
        transpose_item(a.in[I_FD] + (size_t)DM * DFF, DFF, DM, (bf16*)(ws + WS_W_DN1), 0, scr, r, lane);
    }
    const int gt = bid * NTHR + tid, NGT = G * NTHR;
    { u32x4 z = (u32x4){0u, 0u, 0u, 0u};
      u32x4* p1 = (u32x4*)((bf16*)(ws + WS_W_SSMIN) + (size_t)SSM_INV * DM); for (int i = gt; i < (SSM_INP - SSM_INV) * DM / 8; i += NGT) p1[i] = z;
      u32x4* p2 = (u32x4*)((bf16*)(ws + WS_XN) + (size_t)MV * DM); for (int i = gt; i < (MPAD - MV) * DM / 8; i += NGT) p2[i] = z; }
    { f32x2* rope = (f32x2*)(ws + WS_ROPE);
      for (int i = gt; i < SEQ * 8; i += NGT) { const int pos = i >> 3, k = i & 7;
          const double invf = k == 0 ? 1.0 : k == 1 ? 0.19392274474868576 : k == 2 ? 0.03760603093086393 : k == 3 ? 0.007292664737217109 : k == 4 ? 0.001414213562373095 : k == 5 ? 0.0002742481756762073 : k == 6 ? 5.318295896944988e-05 : 1.031338537721246e-05;
          const double rev = (double)pos * invf * 0.15915494309189535; const float fr = (float)(rev - __builtin_floor(rev));
          rope[i] = (f32x2){__builtin_amdgcn_cosf(fr), __builtin_amdgcn_sinf(fr)}; } }
    const f32x4* g4 = (const f32x4*)(a.in[I_NG]);
    for (int row = gw; row < MV; row += NGW) {
        const f32x4* src = (const f32x4*)(row < MPR ? a.in[I_XP] + (size_t)row * DM : a.in[I_XS] + (size_t)(row - MPR) * DM);
        f32x4* dst = (f32x4*)(a.out + (size_t)row * DM);
        f32x4 v[4]; float ss = 0.f;
#pragma unroll
        for (int j = 0; j < 4; ++j) { v[j] = src[lane + 64 * j]; ss += (v[j].x * v[j].x + v[j].y * v[j].y) + (v[j].z * v[j].z + v[j].w * v[j].w); dst[lane + 64 * j] = v[j]; }
        const float r = __builtin_amdgcn_rsqf(wave_sum(ss) * (1.f / DM) + EPS);
        u32x2* o = (u32x2*)((bf16*)(ws + WS_XN) + (size_t)row * DM);
#pragma unroll
        for (int j = 0; j < 4; ++j) { const f32x4 g = g4[lane + 64 * j]; u32x2 w; w.x = pk2(v[j].x * r * g.x, v[j].y * r * g.y); w.y = pk2(v[j].z * r * g.z, v[j].w * r * g.w); o[lane + 64 * j] = w; }
    }
}
template <bool SECOND>
__device__ __forceinline__ void nrn_rows(const Args& a, const float* g1, const float* g2, int G, int bid) {
    const int tid = threadIdx.x, lane = tid & 63, wave = tid >> 6;
    const int gw = bid * NWAVES + wave, NGW = G * NWAVES;
    const bf16* mix = (const bf16*)(a.ws + WS_MIX); bf16* xn = (bf16*)(a.ws + WS_XN);
    const f32x4* g14 = (const f32x4*)g1; const f32x4* g24 = (const f32x4*)g2;
    for (int row = gw; row < MV; row += NGW) {
        const u32x2* mp = (const u32x2*)(mix + (size_t)row * DM);
        f32x4* xp = (f32x4*)(a.out + (size_t)row * DM);
        f32x4 m[4], xv[4]; float ss = 0.f;
#pragma unroll
        for (int j = 0; j < 4; ++j) { const u32x2 w = mp[lane + 64 * j]; m[j] = (f32x4){bflo(w.x), bfhi(w.x), bflo(w.y), bfhi(w.y)}; xv[j] = xp[lane + 64 * j];
            ss += (m[j].x * m[j].x + m[j].y * m[j].y) + (m[j].z * m[j].z + m[j].w * m[j].w); }
        const float r1 = __builtin_amdgcn_rsqf(wave_sum(ss) * (1.f / DM) + EPS);
        float s2 = 0.f;
#pragma unroll
        for (int j = 0; j < 4; ++j) { const f32x4 g = g14[lane + 64 * j]; xv[j] = xv[j] + m[j] * r1 * g; xp[lane + 64 * j] = xv[j];
            s2 += (xv[j].x * xv[j].x + xv[j].y * xv[j].y) + (xv[j].z * xv[j].z + xv[j].w * xv[j].w); }
        if (SECOND) {
            const float r2 = __builtin_amdgcn_rsqf(wave_sum(s2) * (1.f / DM) + EPS);
            u32x2* o = (u32x2*)(xn + (size_t)row * DM);
#pragma unroll
            for (int j = 0; j < 4; ++j) { const f32x4 g = g24[lane + 64 * j]; u32x2 w; w.x = pk2(xv[j].x * r2 * g.x, xv[j].y * r2 * g.y); w.y = pk2(xv[j].z * r2 * g.z, xv[j].w * r2 * g.w); o[lane + 64 * j] = w; }
        }
    }
}

__device__ __forceinline__ void load8_rope(const bf16* hp, int dg, const f32x2* rp, float (&o)[8]) {
    const u32x4 w = *(const u32x4*)(hp + dg * 8); unpack8(w, o);
    if (dg < 2) { float p[8]; const u32x4 w2 = *(const u32x4*)(hp + (1 - dg) * 8); unpack8(w2, p);
#pragma unroll
        for (int j = 0; j < 8; ++j) { const f32x2 cs = rp[j]; o[j] = dg == 0 ? o[j] * cs.x - p[j] * cs.y : o[j] * cs.x + p[j] * cs.y; } }
}
__device__ __forceinline__ void attn_phase(const Args& a, LAS unsigned char* lds, int G, int bid) {
    LAS bf16* Qs = (LAS bf16*)lds;
    LAS bf16* Ks = (LAS bf16*)(lds + 36864);
    LAS bf16* Vt = (LAS bf16*)(lds + 64512);
    const int tid = threadIdx.x, lane = tid & 63, w = tid >> 6, fr = lane & 15, fq = lane >> 4;
    const bf16* P0 = (const bf16*)(a.ws + WS_P0); bf16* CAT = (bf16*)(a.ws + WS_CAT);
    const f32x2* rope = (const f32x2*)(a.ws + WS_ROPE);
    for (int u = bid; u < 528; u += G) {
        const bool smp = u >= 512;
        int b, c = 0, kvh, nq, nkc = 0, nvalid, qrow0;
        if (!smp) { kvh = u & 1; c = (u >> 1) & 127; b = u >> 8; nq = 64; nkc = (c < 2 ? c : 2) + 1; nvalid = 64 * nkc; qrow0 = b * SEQ + c * 64; }
        else { const int v = u - 512; kvh = v & 1; b = v >> 1; nq = 16; nvalid = 144; qrow0 = MPR + b * 16; }
#pragma unroll
        for (int it = 0; it < 4; ++it) { const int item = tid + NTHR * it, q = item >> 3, dg = item & 7, hh = q >> 6, i = q & 63;
            u32x4 o = (u32x4){0u, 0u, 0u, 0u};
            if (i < nq) { const int pos = smp ? 4096 + i : c * 64 + i; float f[8]; load8_rope(P0 + (size_t)(qrow0 + i) * AB_IN + (4 * kvh + hh) * 64, dg, rope + pos * 8, f);
#pragma unroll
                for (int j = 0; j < 8; ++j) f[j] *= 0.125f;
                o = pack8(f); }
            *(LAS u32x4*)(Qs + q * 72 + dg * 8) = o; }
#pragma unroll
        for (int it = 0; it < 3; ++it) { const int item = tid + NTHR * it, kr = item >> 3, dg = item & 7;
            u32x4 ko = (u32x4){0u, 0u, 0u, 0u}, vo = ko;
            if (kr < nvalid) {
                if (smp && kr < 128) { const size_t off = ((size_t)(b * 128 + kr) * 2 + kvh) * 64 + dg * 8;
                    const f32x4 k0 = *(const f32x4*)(a.in[I_CK] + off), k1 = *(const f32x4*)(a.in[I_CK] + off + 4), v0 = *(const f32x4*)(a.in[I_CV] + off), v1 = *(const f32x4*)(a.in[I_CV] + off + 4);
                    ko.x = pk2(k0.x, k0.y); ko.y = pk2(k0.z, k0.w); ko.z = pk2(k1.x, k1.y); ko.w = pk2(k1.z, k1.w); vo.x = pk2(v0.x, v0.y); vo.y = pk2(v0.z, v0.w); vo.z = pk2(v1.x, v1.y); vo.w = pk2(v1.z, v1.w); }
                else { int row, pos; if (smp) { row = MPR + b * 16 + (kr - 128); pos = 4096 + kr - 128; } else { pos = (c - nkc + 1 + (kr >> 6)) * 64 + (kr & 63); row = b * SEQ + pos; }
                    const bf16* rp = P0 + (size_t)row * AB_IN; float f[8]; load8_rope(rp + 512 + kvh * 64, dg, rope + pos * 8, f); ko = pack8(f);
                    vo = *(const u32x4*)(rp + 640 + kvh * 64 + dg * 8); }
            }
            *(LAS u32x4*)(Ks + kr * 72 + dg * 8) = ko;
            LAS bf16* vp = Vt + (dg * 8) * 200 + kr;
            vp[0 * 200] = (bf16)(vo.x & 0xffffu); vp[1 * 200] = (bf16)(vo.x >> 16); vp[2 * 200] = (bf16)(vo.y & 0xffffu); vp[3 * 200] = (bf16)(vo.y >> 16);
            vp[4 * 200] = (bf16)(vo.z & 0xffffu); vp[5 * 200] = (bf16)(vo.z >> 16); vp[6 * 200] = (bf16)(vo.w & 0xffffu); vp[7 * 200] = (bf16)(vo.w >> 16); }
        __syncthreads();
        const int hh = w >> 1, qh = w & 1;
        if (qh * 32 < nq) {
            f32x4 s[12][2];
#pragma unroll
            for (int kt = 0; kt < 12; ++kt) { s[kt][0] = (f32x4){0.f, 0.f, 0.f, 0.f}; s[kt][1] = s[kt][0]; }
#pragma unroll
            for (int ks = 0; ks < 2; ++ks) {
                bf16x8 bq[2];
#pragma unroll
                for (int qt = 0; qt < 2; ++qt) bq[qt] = *(const LAS bf16x8*)(Qs + (w * 32 + qt * 16 + fr) * 72 + ks * 32 + fq * 8);
#pragma unroll
                for (int kt = 0; kt < 12; ++kt) if (kt * 16 < nvalid) { const bf16x8 ak = *(const LAS bf16x8*)(Ks + (kt * 16 + fr) * 72 + ks * 32 + fq * 8);
                    s[kt][0] = mfma16(ak, bq[0], s[kt][0]); s[kt][1] = mfma16(ak, bq[1], s[kt][1]); }
            }
            const float sink = a.in[I_SINK][4 * kvh + hh];
            float inv[2];
#pragma unroll
            for (int qt = 0; qt < 2; ++qt) {
                float m = sink;
#pragma unroll
                for (int kt = 0; kt < 12; ++kt) if (kt * 16 < nvalid) m = fmaxf(fmaxf(m, fmaxf(s[kt][qt][0], s[kt][qt][1])), fmaxf(s[kt][qt][2], s[kt][qt][3]));
                m = fmaxf(m, __shfl_xor(m, 16)); m = fmaxf(m, __shfl_xor(m, 32));
                float sum = 0.f;
#pragma unroll
                for (int kt = 0; kt < 12; ++kt) { if (kt * 16 < nvalid) {
#pragma unroll
                        for (int i = 0; i < 4; ++i) { const float p = __expf(s[kt][qt][i] - m); s[kt][qt][i] = p; sum += p; } }
                    else s[kt][qt] = (f32x4){0.f, 0.f, 0.f, 0.f}; }
                sum += __shfl_xor(sum, 16); sum += __shfl_xor(sum, 32);
                inv[qt] = 1.0f / (sum + __expf(sink - m));
            }
            f32x4 o[4][2];
#pragma unroll
            for (int dt = 0; dt < 4; ++dt) { o[dt][0] = (f32x4){0.f, 0.f, 0.f, 0.f}; o[dt][1] = o[dt][0]; }
#pragma unroll
            for (int kk = 0; kk < 6; ++kk) if (kk * 32 < nvalid) {
                bf16x8 bp[2];
#pragma unroll
                for (int qt = 0; qt < 2; ++qt) { u32x4 t; t.x = pk2(s[2 * kk][qt][0], s[2 * kk][qt][1]); t.y = pk2(s[2 * kk][qt][2], s[2 * kk][qt][3]); t.z = pk2(s[2 * kk + 1][qt][0], s[2 * kk + 1][qt][1]); t.w = pk2(s[2 * kk + 1][qt][2], s[2 * kk + 1][qt][3]);
                    bp[qt] = __builtin_bit_cast(bf16x8, t); }
#pragma unroll
                for (int dt = 0; dt < 4; ++dt) { const LAS bf16* vp = Vt + (dt * 16 + fr) * 200 + kk * 32 + 4 * fq;
                    const u32x2 lo = *(const LAS u32x2*)vp, hi = *(const LAS u32x2*)(vp + 16); const u32x4 t = (u32x4){lo.x, lo.y, hi.x, hi.y}; const bf16x8 av = __builtin_bit_cast(bf16x8, t);
                    o[dt][0] = mfma16(av, bp[0], o[dt][0]); o[dt][1] = mfma16(av, bp[1], o[dt][1]); }
            }
#pragma unroll
            for (int qt = 0; qt < 2; ++qt) { const int tok = qh * 32 + qt * 16 + fr;
                if (tok < nq) { bf16* op = CAT + (size_t)(qrow0 + tok) * DM + (4 * kvh + hh) * 64 + 4 * fq;
#pragma unroll
                    for (int dt = 0; dt < 4; ++dt) { const f32x4 v = o[dt][qt] * inv[qt]; u32x2 wv; wv.x = pk2(v[0], v[1]); wv.y = pk2(v[2], v[3]); *(u32x2*)(op + dt * 16) = wv; } } }
        }
        __syncthreads();
    }
    const int gt = bid * NTHR + tid, NGT = G * NTHR;
    const float* scw = a.in[I_SCW];
    for (int it = gt; it < MV * 64; it += NGT) { const int row = it >> 6, ch = (it & 63) * 8;
        int t, L, bb; if (row < MPR) { bb = row >> 13; t = row & (SEQ - 1); L = SEQ; } else { bb = (row - MPR) >> 4; t = (row - MPR) & 15; L = 16; }
        float acc[8], uc[8];
#pragma unroll
        for (int j = 0; j < 8; ++j) acc[j] = 0.f;
#pragma unroll
        for (int d = 0; d < 3; ++d) {
            const int tt = t - 2 + d; float uu[8];
            if (tt >= 0) { const bf16* rp = P0 + (size_t)(row - 2 + d) * AB_IN; float gc[8], hx[8]; unpack8(*(const u32x4*)(rp + 1280 + ch), gc); unpack8(*(const u32x4*)(rp + 1792 + ch), hx);
#pragma unroll
                for (int j = 0; j < 8; ++j) uu[j] = gc[j] * hx[j]; }
            else if (row >= MPR) { const float* hp = a.in[I_SCONV] + ((size_t)bb * 2 + (2 + tt)) * 512 + ch;
#pragma unroll
                for (int j = 0; j < 8; ++j) uu[j] = hp[j]; }
            else {
#pragma unroll
                for (int j = 0; j < 8; ++j) uu[j] = 0.f; }
#pragma unroll
            for (int j = 0; j < 8; ++j) { acc[j] += scw[d * 512 + ch + j] * uu[j]; if (d == 2) uc[j] = uu[j]; }
        }
        float gb[8]; unpack8(*(const u32x4*)(P0 + (size_t)row * AB_IN + 768 + ch), gb);
#pragma unroll
        for (int j = 0; j < 8; ++j) acc[j] *= gb[j];
        *(u32x4*)(CAT + (size_t)row * DM + 512 + ch) = pack8(acc);
        if (t >= L - 2) { float* op = a.out + (row < MPR ? O_SCP + ((size_t)bb * 2 + (t - (L - 2))) * 512 : O_SCS + ((size_t)bb * 2 + (t - (L - 2))) * 512) + ch;
#pragma unroll
            for (int j = 0; j < 8; ++j) op[j] = uc[j]; }
    }
    for (int it = gt; it < (256 + 128) * 32; it += NGT) { const int ri = it >> 5, kvh = (it >> 4) & 1, dg = (it >> 1) & 7, isv = it & 1;
        int row, pos; float* op;
        if (ri < 256) { const int bb = ri >> 7, j = ri & 127; pos = SEQ - 128 + j; row = bb * SEQ + pos; op = a.out + (isv ? O_VP : O_KP) + ((size_t)(bb * 128 + j) * 2 + kvh) * 64 + dg * 8; }
        else { const int r2 = ri - 256, bb = r2 >> 4, j = r2 & 15; pos = 4096 + j; row = MPR + r2; op = a.out + (isv ? O_VS : O_KS) + ((size_t)(bb * 16 + j) * 2 + kvh) * 64 + dg * 8; }
        const bf16* rp = P0 + (size_t)row * AB_IN; float f[8];
        if (isv) unpack8(*(const u32x4*)(rp + 640 + kvh * 64 + dg * 8), f); else load8_rope(rp + 512 + kvh * 64, dg, rope + pos * 8, f);
        *(f32x4*)op = (f32x4){f[0], f[1], f[2], f[3]}; *(f32x4*)(op + 4) = (f32x4){f[4], f[5], f[6], f[7]};
    }
}

__device__ __forceinline__ void ssmconv_phase(const Args& a, int G, int bid) {
    const int tid = threadIdx.x, gt = bid * NTHR + tid, NGT = G * NTHR;
    bf16* XBC = (bf16*)(a.ws + WS_XBC); const bf16* HALO = (const bf16*)(a.ws + WS_HALO);
    const float* cw = a.in[I_SSMCW]; const float* cb = a.in[I_SSMCB];
    for (int it = gt; it < 264 * 384; it += NGT) {
        int cgp, r0, nrows; const bf16* hal = nullptr; const float* hist = nullptr; float* outc = nullptr;
        if (it < 256 * 384) { const int blk = it / 384; cgp = it - blk * 384; r0 = blk * 64; nrows = 64; if (blk & 127) hal = HALO + (size_t)(blk - 1) * 3 * XBCW; if ((blk & 127) == 127) outc = a.out + O_CCP + (size_t)(blk >> 7) * 3 * XBCW; }
        else { const int v = it - 256 * 384, bs = v / 384; cgp = v - bs * 384; r0 = MPR + bs * 16; nrows = 16; hist = a.in[I_SSMCONV] + (size_t)bs * 3 * XBCW; outc = a.out + O_CCS + (size_t)bs * 3 * XBCW; }
        const int col = cgp * 8;
        float h0[8], h1[8], h2[8], w0[8], w1[8], w2[8], w3[8], bz[8];
#pragma unroll
        for (int j = 0; j < 8; ++j) { h0[j] = 0.f; h1[j] = 0.f; h2[j] = 0.f; w0[j] = cw[col + j]; w1[j] = cw[XBCW + col + j]; w2[j] = cw[2 * XBCW + col + j]; w3[j] = cw[3 * XBCW + col + j]; bz[j] = cb[col + j]; }
        if (hal) { unpack8(*(const u32x4*)(hal + col), h0); unpack8(*(const u32x4*)(hal + XBCW + col), h1); unpack8(*(const u32x4*)(hal + 2 * XBCW + col), h2); }
        if (hist) {
#pragma unroll
            for (int j = 0; j < 8; ++j) { h0[j] = hist[col + j]; h1[j] = hist[XBCW + col + j]; h2[j] = hist[2 * XBCW + col + j]; } }
        bf16* p = XBC + (size_t)r0 * XBCW + col;
        for (int r = 0; r < nrows; r += 4) {
            u32x4 raw[4];
#pragma unroll
            for (int q = 0; q < 4; ++q) raw[q] = *(const u32x4*)(p + (size_t)(r + q) * XBCW);
#pragma unroll
            for (int q = 0; q < 4; ++q) { float cur[8], y[8]; unpack8(raw[q], cur);
#pragma unroll
                for (int j = 0; j < 8; ++j) { y[j] = silu(w0[j] * h0[j] + w1[j] * h1[j] + w2[j] * h2[j] + w3[j] * cur[j] + bz[j]); h0[j] = h1[j]; h1[j] = h2[j]; h2[j] = cur[j]; }
                *(u32x4*)(p + (size_t)(r + q) * XBCW) = pack8(y); }
        }
        if (outc) {
#pragma unroll
            for (int j = 0; j < 8; ++j) { outc[col + j] = h0[j]; outc[XBCW + col + j] = h1[j]; outc[2 * XBCW + col + j] = h2[j]; } }
    }
    float* DT = (float*)(a.ws + WS_DT); const float* dtb = a.in[I_DTB];
    for (int it = gt; it < MV * 32; it += NGT) { const float x = DT[it] + dtb[it & 31]; const float e = __expf(x);
        DT[it] = x > 20.f ? x : (e < 1e-2f ? e * (1.f - e * (0.5f - e * 0.33333333f)) : __logf(1.f + e)); }
}

constexpr int S_XT = 0, S_XW = 9216, S_BM = 18432, S_BT = 35840, S_CM = 54272, S_WM = 71680, S_HA = 80896, S_SC = 98304;
template <bool FULL>
__device__ __forceinline__ void ssd_stream(const Args& a, LAS unsigned char* lds, f32x4 (&st)[2][2], const int row0, const int nchunks, const int nvalid, const int h, const float a_h, const float d_h, float& logdec) {
    LAS bf16* xT = (LAS bf16*)(lds + S_XT); LAS bf16* xwT = (LAS bf16*)(lds + S_XW); LAS bf16* Bm = (LAS bf16*)(lds + S_BM); LAS bf16* BT = (LAS bf16*)(lds + S_BT);
    LAS bf16* Cm = (LAS bf16*)(lds + S_CM); LAS bf16* Wm = (LAS bf16*)(lds + S_WM); LAS bf16* HA = (LAS bf16*)(lds + S_HA); LAS float* scal = (LAS float*)(lds + S_SC);
    const int tid = threadIdx.x, lane = tid & 63, w = tid >> 6, fr = lane & 15, fq = lane >> 4, nq4 = w & 3, pr = w >> 2, g = h >> 3;
    const bf16* XBC = (const bf16*)(a.ws + WS_XBC); bf16* Z = (bf16*)(a.ws + WS_Z); const float* DT = (const float*)(a.ws + WS_DT);
    u32x4 px, pb[2], pc[2]; float pdt = 0.f;
    const u32x4 zero4 = (u32x4){0u, 0u, 0u, 0u};
    const int xl = tid >> 3, xpg = tid & 7;
#define SSD_PREFETCH(ci) do { const int rb_ = row0 + 64 * (ci); \
        px = xl < nvalid ? *(const u32x4*)(XBC + (size_t)(rb_ + xl) * XBCW + h * 64 + xpg * 8) : zero4; \
        _Pragma("unroll") for (int k_ = 0; k_ < 2; ++k_) { const int item_ = tid + NTHR * k_, l_ = item_ >> 4, ng_ = item_ & 15; \
            pb[k_] = l_ < nvalid ? *(const u32x4*)(XBC + (size_t)(rb_ + l_) * XBCW + 2048 + g * 128 + ng_ * 8) : zero4; \
            if (FULL) pc[k_] = l_ < nvalid ? *(const u32x4*)(XBC + (size_t)(rb_ + l_) * XBCW + 2560 + g * 128 + ng_ * 8) : zero4; } \
        if (w == 0) pdt = lane < nvalid ? DT[(size_t)(rb_ + lane) * 32 + h] : 0.f; } while (0)
    SSD_PREFETCH(0);
    for (int ci = 0; ci < nchunks; ++ci) {
        const int rbase = row0 + 64 * ci;
        if (w == 0) { const float dtl = pdt; float v = dtl * a_h;
#pragma unroll
            for (int o = 1; o < 64; o <<= 1) { const float t = __shfl_up(v, o); if (lane >= o) v += t; }
            const float tot = __shfl(v, 63);
            scal[lane] = v; scal[64 + lane] = __expf(v); scal[128 + lane] = __expf(tot - v) * dtl; scal[192 + lane] = dtl; if (lane == 0) scal[256] = tot; }
        __syncthreads();
        { const float dte = scal[128 + xl]; float f[8]; unpack8(px, f);
          LAS bf16* p1 = xT + (xpg * 8) * 72 + xl; LAS bf16* p2 = xwT + (xpg * 8) * 72 + xl;
#pragma unroll
          for (int j = 0; j < 8; ++j) { p1[j * 72] = f2bf(f[j]); p2[j * 72] = f2bf(f[j] * dte); } }
#pragma unroll
        for (int k = 0; k < 2; ++k) { const int item = tid + NTHR * k, l = item >> 4, ng = item & 15;
            *(LAS u32x4*)(Bm + l * 136 + ng * 8) = pb[k];
            LAS bf16* bp = BT + (ng * 8) * 72 + l; const u32x4 v = pb[k];
            bp[0 * 72] = (bf16)(v.x & 0xffffu); bp[1 * 72] = (bf16)(v.x >> 16); bp[2 * 72] = (bf16)(v.y & 0xffffu); bp[3 * 72] = (bf16)(v.y >> 16);
            bp[4 * 72] = (bf16)(v.z & 0xffffu); bp[5 * 72] = (bf16)(v.z >> 16); bp[6 * 72] = (bf16)(v.w & 0xffffu); bp[7 * 72] = (bf16)(v.w >> 16);
            if (FULL) *(LAS u32x4*)(Cm + l * 136 + ng * 8) = pc[k]; }
        if (FULL) {
#pragma unroll
            for (int nt = 0; nt < 2; ++nt)
#pragma unroll
                for (int pt = 0; pt < 2; ++pt) { const f32x4 v = st[nt][pt]; u32x2 wv; wv.x = pk2(v[0], v[1]); wv.y = pk2(v[2], v[3]);
                    *(LAS u32x2*)(HA + (32 * pr + 16 * pt + fr) * 136 + 32 * nq4 + 16 * nt + 4 * fq) = wv; } }
        if (ci + 1 < nchunks) SSD_PREFETCH(ci + 1);
        __syncthreads();
        { const float tot = scal[256]; logdec += tot; const float dec = __expf(tot);
#pragma unroll
          for (int nt = 0; nt < 2; ++nt)
#pragma unroll
              for (int pt = 0; pt < 2; ++pt) st[nt][pt] = st[nt][pt] * dec;
#pragma unroll
          for (int ks = 0; ks < 2; ++ks) { bf16x8 af[2], bx[2];
#pragma unroll
              for (int t = 0; t < 2; ++t) { af[t] = *(const LAS bf16x8*)(BT + (32 * nq4 + 16 * t + fr) * 72 + ks * 32 + fq * 8); bx[t] = *(const LAS bf16x8*)(xwT + (32 * pr + 16 * t + fr) * 72 + ks * 32 + fq * 8); }
#pragma unroll
              for (int nt = 0; nt < 2; ++nt)
#pragma unroll
                  for (int pt = 0; pt < 2; ++pt) st[nt][pt] = mfma16(af[nt], bx[pt], st[nt][pt]); } }
        if (FULL) {
#pragma unroll
            for (int k2 = 0; k2 < 2; ++k2) { const int id = 2 * w + k2, stl = id >> 2, lt = id & 3; const int l = 16 * lt + fr;
                u32x2 wv = (u32x2){0u, 0u};
                if (stl <= lt) { f32x4 acc = (f32x4){0.f, 0.f, 0.f, 0.f};
#pragma unroll
                    for (int ks = 0; ks < 4; ++ks) { const bf16x8 af = *(const LAS bf16x8*)(Bm + (16 * stl + fr) * 136 + ks * 32 + fq * 8), bc = *(const LAS bf16x8*)(Cm + l * 136 + ks * 32 + fq * 8); acc = mfma16(af, bc, acc); }
                    const float al = scal[l]; float v[4];
#pragma unroll
                    for (int i = 0; i < 4; ++i) { const int s = 16 * stl + 4 * fq + i; v[i] = s <= l ? acc[i] * __expf(al - scal[s]) * scal[192 + s] : 0.f; }
                    wv.x = pk2(v[0], v[1]); wv.y = pk2(v[2], v[3]); }
                *(LAS u32x2*)(Wm + l * 72 + 16 * stl + 4 * fq) = wv; }
            __syncthreads();
#pragma unroll
            for (int k2 = 0; k2 < 2; ++k2) { const int id = 2 * w + k2, pt = id >> 2, lt = id & 3; const int l = 16 * lt + fr;
                bf16* zp = Z + (size_t)(rbase + l) * ZW + h * 64 + 16 * pt + 4 * fq;
                u32x2 zr = (u32x2){0u, 0u}; if (l < nvalid) zr = *(const u32x2*)zp;
                f32x4 dg = (f32x4){0.f, 0.f, 0.f, 0.f}, of = dg;
#pragma unroll
                for (int ks = 0; ks < 2; ++ks) { const bf16x8 af = *(const LAS bf16x8*)(xT + (16 * pt + fr) * 72 + ks * 32 + fq * 8), bw = *(const LAS bf16x8*)(Wm + l * 72 + ks * 32 + fq * 8); dg = mfma16(af, bw, dg); }
#pragma unroll
                for (int ks = 0; ks < 4; ++ks) { const bf16x8 af = *(const LAS bf16x8*)(HA + (16 * pt + fr) * 136 + ks * 32 + fq * 8), bc = *(const LAS bf16x8*)(Cm + l * 136 + ks * 32 + fq * 8); of = mfma16(af, bc, of); }
                const float e = scal[64 + l]; const float zf[4] = {bflo(zr.x), bfhi(zr.x), bflo(zr.y), bfhi(zr.y)}; float y[4];
#pragma unroll
                for (int i = 0; i < 4; ++i) { const float xv = bf1(xT[(16 * pt + 4 * fq + i) * 72 + l]); y[i] = (dg[i] + of[i] * e + d_h * xv) * silu(zf[i]); }
                if (l < nvalid) { u32x2 wv; wv.x = pk2(y[0], y[1]); wv.y = pk2(y[2], y[3]); *(u32x2*)zp = wv; } }
        }
        __syncthreads();
    }
#undef SSD_PREFETCH
}
__device__ __forceinline__ void ssd_pass_a(const Args& a, LAS unsigned char* lds, int G, int bid) {
    const int tid = threadIdx.x;
    float* SEG = (float*)(a.ws + WS_SEG); float* SEGD = (float*)(a.ws + WS_SEGD);
    for (int u = bid; u < 192; u += G) { const int bh = u / 3, seg = u - bh * 3, b = bh >> 5, h = bh & 31;
        f32x4 st[2][2];
#pragma unroll
        for (int i = 0; i < 2; ++i) { st[i][0] = (f32x4){0.f, 0.f, 0.f, 0.f}; st[i][1] = st[i][0]; }
        float logdec = 0.f; const float a_h = -__expf(a.in[I_ALOG][h]);
        ssd_stream<false>(a, lds, st, b * SEQ + seg * 2048, 32, 64, h, a_h, 0.f, logdec);
        f32x4* sp = (f32x4*)(SEG + (size_t)u * 8192);
#pragma unroll
        for (int i = 0; i < 2; ++i)
#pragma unroll
            for (int j = 0; j < 2; ++j) sp[(i * 2 + j) * NTHR + tid] = st[i][j];
        if (tid == 0) SEGD[u] = logdec;
    }
}
__device__ __forceinline__ void ssd_pass_b(const Args& a, LAS unsigned char* lds, int G, int bid) {
    const int tid = threadIdx.x, lane = tid & 63, w = tid >> 6, fr = lane & 15, fq = lane >> 4, nq4 = w & 3, pr = w >> 2;
    const float* SEG = (const float*)(a.ws + WS_SEG); const float* SEGD = (const float*)(a.ws + WS_SEGD);
    for (int u = bid; u < 512; u += G) {
        f32x4 st[2][2]; float logdec = 0.f;
        if (u < 256) { const int bh = u >> 2, seg = u & 3, b = bh >> 5, h = bh & 31;
#pragma unroll
            for (int i = 0; i < 2; ++i) { st[i][0] = (f32x4){0.f, 0.f, 0.f, 0.f}; st[i][1] = st[i][0]; }
            for (int s = 0; s < seg; ++s) { const float dec = __expf(SEGD[bh * 3 + s]); const f32x4* sp = (const f32x4*)(SEG + (size_t)(bh * 3 + s) * 8192);
#pragma unroll
                for (int i = 0; i < 2; ++i)
#pragma unroll
                    for (int j = 0; j < 2; ++j) st[i][j] = st[i][j] * dec + sp[(i * 2 + j) * NTHR + tid]; }
            const float a_h = -__expf(a.in[I_ALOG][h]), d_h = a.in[I_SSMD][h];
            ssd_stream<true>(a, lds, st, b * SEQ + seg * 2048, 32, 64, h, a_h, d_h, logdec);
            if (seg == 3) { float* op = a.out + O_SSP + (size_t)bh * 8192;
#pragma unroll
                for (int nt = 0; nt < 2; ++nt)
#pragma unroll
                    for (int pt = 0; pt < 2; ++pt) *(f32x4*)(op + (32 * pr + 16 * pt + fr) * 128 + 32 * nq4 + 16 * nt + 4 * fq) = st[nt][pt]; }
        } else { const int v = u - 256, bs = v >> 5, h = v & 31;
            const float* ip = a.in[I_SSM] + (size_t)v * 8192;
#pragma unroll
            for (int nt = 0; nt < 2; ++nt)
#pragma unroll
                for (int pt = 0; pt < 2; ++pt) st[nt][pt] = *(const f32x4*)(ip + (32 * pr + 16 * pt + fr) * 128 + 32 * nq4 + 16 * nt + 4 * fq);
            const float a_h = -__expf(a.in[I_ALOG][h]), d_h = a.in[I_SSMD][h];
            ssd_stream<true>(a, lds, st, MPR + bs * 16, 1, 16, h, a_h, d_h, logdec);
            float* op = a.out + O_SSS + (size_t)v * 8192;
#pragma unroll
            for (int nt = 0; nt < 2; ++nt)
#pragma unroll
                for (int pt = 0; pt < 2; ++pt) *(f32x4*)(op + (32 * pr + 16 * pt + fr) * 128 + 32 * nq4 + 16 * nt + 4 * fq) = st[nt][pt];
        }
    }
}
__device__ __forceinline__ void gnorm_phase(const Args& a, int G, int bid) {
    const int tid = threadIdx.x, lane = tid & 63, wave = tid >> 6, gw = bid * NWAVES + wave, NGW = G * NWAVES;
    bf16* Z = (bf16*)(a.ws + WS_Z); const float* ng = a.in[I_SSMNG];
    for (int it = gw; it < MV * 4; it += NGW) { const int row = it >> 2, g = it & 3;
        u32x4* p = (u32x4*)(Z + (size_t)row * ZW + g * 512 + lane * 8); float f[8]; unpack8(*p, f);
        float ss = 0.f;
#pragma unroll
        for (int j = 0; j < 8; ++j) ss += f[j] * f[j];
        const float r = __builtin_amdgcn_rsqf(wave_sum(ss) * (1.f / 512.f) + EPS);
        const f32x4 g0 = *(const f32x4*)(ng + g * 512 + lane * 8), g1 = *(const f32x4*)(ng + g * 512 + lane * 8 + 4);
        f[0] *= r * g0.x; f[1] *= r * g0.y; f[2] *= r * g0.z; f[3] *= r * g0.w; f[4] *= r * g1.x; f[5] *= r * g1.y; f[6] *= r * g1.z; f[7] *= r * g1.w;
        *p = pack8(f); }
}

#ifndef MK_ONE_LAUNCH
#define MK_ONE_LAUNCH 1
#endif
constexpr int N_PHASES = 18;
__global__ void __launch_bounds__(NTHR, 2) mega_fwd(Args args) {
    extern __shared__ __attribute__((aligned(16))) unsigned char lds_raw[];
    LAS unsigned char* lds = (LAS unsigned char*)lds_raw;
    cg::grid_group grid = cg::this_grid();
    const int G = gridDim.x, bid = blockIdx.x;
    unsigned char* ws = args.ws;
    const int lo = args.ph_lo, hi = args.ph_hi;
    const float* NG = args.in[I_NG];
    bf16* XN = (bf16*)(ws + WS_XN); bf16* MIX = (bf16*)(ws + WS_MIX); bf16* HB = (bf16*)(ws + WS_H);
#define IN(k) (lo <= (k) && (k) < hi)
#define SEAM(k) do { if (IN(k) && IN((k) + 1)) grid.sync(); } while (0)
#define GEMM_SPLIT(Aptr, Wptr, NN, KK, E) do { pg8::Gemm g_{(const pg8::bf16_t*)(Aptr), (const pg8::bf16_t*)(Wptr), MPAD, (NN), (KK)}; pg8::StaticOrder S_; S_.init(MPAD, (NN), G, bid); \
        pg8::gemm_phase<pg8::EpiSplit, pg8::StaticOrder, true, true>(lds, g_, S_, E); } while (0)
#define GEMM_SWIGLU(Aptr, Wptr, E) do { pg8::Gemm g_{(const pg8::bf16_t*)(Aptr), (const pg8::bf16_t*)(Wptr), MPAD, 2 * DFF, DM}; pg8::StaticOrder S_; S_.init(MPAD, 2 * DFF, G, bid); \
        pg8::gemm_phase<pg8::EpiSwiGLU, pg8::StaticOrder, true, true>(lds, g_, S_, E); } while (0)
    if (IN(0)) { p0_prologue(args, lds, G, bid); } SEAM(0);
    if (IN(1)) { pg8::EpiSplit E{(bf16*)(ws + WS_P0), AB_IN, AB_IN, nullptr, 0, AB_IN, nullptr, 0, nullptr}; GEMM_SPLIT(XN, ws + WS_W_ABIN, AB_IN, DM, E); } SEAM(1);
    if (IN(2)) { attn_phase(args, lds, G, bid); } SEAM(2);
    if (IN(3)) { pg8::EpiSplit E{MIX, DM, DM, nullptr, 0, DM, nullptr, 0, nullptr}; GEMM_SPLIT(ws + WS_CAT, ws + WS_W_ABOUT, DM, DM, E); } SEAM(3);
    if (IN(4)) { nrn_rows<true>(args, NG + 1 * DM, NG + 2 * DM, G, bid); } SEAM(4);
    if (IN(5)) { pg8::EpiSwiGLU E{HB, DFF}; GEMM_SWIGLU(XN, ws + WS_W_UP0, E); } SEAM(5);
    if (IN(6)) { pg8::EpiSplit E{MIX, DM, DM, nullptr, 0, DM, nullptr, 0, nullptr}; GEMM_SPLIT(HB, ws + WS_W_DN0, DM, DFF, E); } SEAM(6);
    if (IN(7)) { nrn_rows<true>(args, NG + 3 * DM, NG + 4 * DM, G, bid); } SEAM(7);
    if (IN(8)) { pg8::EpiSplit E{(bf16*)(ws + WS_Z), ZW, ZW, (bf16*)(ws + WS_XBC), XBCW, ZW + XBCW, (float*)(ws + WS_DT), 32, (bf16*)(ws + WS_HALO)}; GEMM_SPLIT(XN, ws + WS_W_SSMIN, SSM_INP, DM, E); } SEAM(8);
    if (IN(9)) { ssmconv_phase(args, G, bid); } SEAM(9);
    if (IN(10)) { ssd_pass_a(args, lds, G, bid); } SEAM(10);
    if (IN(11)) { ssd_pass_b(args, lds, G, bid); } SEAM(11);
    if (IN(12)) { gnorm_phase(args, G, bid); } SEAM(12);
    if (IN(13)) { pg8::EpiSplit E{MIX, DM, DM, nullptr, 0, DM, nullptr, 0, nullptr}; GEMM_SPLIT(ws + WS_Z, ws + WS_W_SSMOUT, DM, ZW, E); } SEAM(13);
    if (IN(14)) { nrn_rows<true>(args, NG + 5 * DM, NG + 6 * DM, G, bid); } SEAM(14);
    if (IN(15)) { pg8::EpiSwiGLU E{HB, DFF}; GEMM_SWIGLU(XN, ws + WS_W_UP1, E); } SEAM(15);
    if (IN(16)) { pg8::EpiSplit E{MIX, DM, DM, nullptr, 0, DM, nullptr, 0, nullptr}; GEMM_SPLIT(HB, ws + WS_W_DN1, DM, DFF, E); } SEAM(16);
    if (IN(17)) { nrn_rows<false>(args, NG + 7 * DM, NG + 7 * DM, G, bid); }
#undef IN
#undef SEAM
}

extern "C" void kernel_launch(void* const* d_in, const int* in_sizes, int n_in, void* d_out, int out_size, void* d_ws, size_t ws_size, hipStream_t stream) {
    static int grid = 0;
    if (grid == 0) {
        if (n_in != 23 || out_size != (int)O_END || ws_size < WS_END) { fprintf(stderr, "kernel_launch: unexpected shapes (n_in %d out %d ws %zu)\n", n_in, out_size, ws_size); grid = -1; return; }
        int dev = 0, cus = 0, per_cu = 0;
        (void)hipGetDevice(&dev); (void)hipDeviceGetAttribute(&cus, hipDeviceAttributeMultiprocessorCount, dev);
        if (hipFuncSetAttribute((const void*)mega_fwd, hipFuncAttributeMaxDynamicSharedMemorySize, LDS_BYTES) != hipSuccess) { fprintf(stderr, "kernel_launch: hipFuncSetAttribute failed\n"); grid = -1; return; }
        if (hipOccupancyMaxActiveBlocksPerMultiprocessor(&per_cu, (const void*)mega_fwd, NTHR, LDS_BYTES) != hipSuccess || per_cu < 1) { fprintf(stderr, "kernel_launch: occupancy query gave %d\n", per_cu); per_cu = 1; }
        (void)hipGetLastError();
        grid = cus * 1;
        if (grid <= 0) grid = 256;
    }
    if (grid < 0) return;
    Args a{};
    for (int i = 0; i < 23; ++i) a.in[i] = (const float*)d_in[i];
    a.out = (float*)d_out; a.ws = (unsigned char*)d_ws;
#if MK_ONE_LAUNCH
    a.ph_lo = 0; a.ph_hi = N_PHASES;
    void* kargs[] = {&a};
    hipError_t e = hipLaunchCooperativeKernel((const void*)mega_fwd, dim3(grid), dim3(NTHR), kargs, LDS_BYTES, stream);
    if (e != hipSuccess) fprintf(stderr, "kernel_launch: cooperative launch failed: %s (grid %d)\n", hipGetErrorString(e), grid);
#else
    for (int p = 0; p < N_PHASES; ++p) { a.ph_lo = p; a.ph_hi = p + 1; hipLaunchKernelGGL(mega_fwd, dim3(grid), dim3(NTHR), LDS_BYTES, stream, a); }
#endif
}
```

```cpp
#include <hip/hip_runtime.h>
#include <hip/hip_cooperative_groups.h>
#include <cstdio>
#include <cstdint>
namespace cg = cooperative_groups;
#define MK_ONE_LAUNCH 1
namespace pg8 {
#define PG8_LAS __attribute__((address_space(3)))
typedef unsigned short bf16_t;
typedef short bf16x8 __attribute__((ext_vector_type(8)));
typedef float f32x4 __attribute__((ext_vector_type(4)));
typedef unsigned u32x4 __attribute__((ext_vector_type(4)));
constexpr int BM = 256, BK = 64, HALF = 128, HTB = HALF * BK * 2  , STAGE_BYTES = 8 * HTB, NXCD = 8, WGM = 8;

__host__ __device__ __forceinline__ int lds_byte(int r, int c) { const int st = (r >> 4) * 2 + (c >> 5), rr = r & 15, cc = c & 31, ob = rr * 64 + cc * 2; return st * 1024 + (ob ^ (((ob >> 9) & 1) << 5)); }
__host__ __device__ __forceinline__ void stage_rc(int b, int& R, int& C) { const int st = b / 1024, sb = b % 1024, swz = sb ^ (((sb >> 9) & 1) << 5); R = (st >> 1) * 16 + swz / 64; C = (st & 1) * 32 + (swz % 64) / 2; }
__host__ __device__ __forceinline__ int perm32(int rho) { const int n = rho >> 4, i = rho & 15; return 8 * (i >> 2) + 4 * n + (i & 3); }

struct Unit { int pm, pn; };
struct Gemm { const bf16_t* A; const bf16_t* Bt; int M, N, K; };

struct StaticOrder {
    int nM, nN, nwg, G, c;
    __host__ __device__ void init(int M, int N, int G_, int c_) { nM = M / BM; nN = N / BM; nwg = nM * nN; G = G_; c = c_; }
    __host__ __device__ bool next(int i, Unit& u) const {
        const long L = (long)i * G + c; if (L >= nwg) return false;
        int wgid = (int)L; { const int q = nwg / NXCD, r = nwg % NXCD, xcd = wgid % NXCD, off = wgid / NXCD; wgid = (xcd < r ? xcd * (q + 1) : r * (q + 1) + (xcd - r) * q) + off; }
        const int nig = WGM * nN, gid = wgid / nig, fm = gid * WGM, gsz = (nM - fm) < WGM ? (nM - fm) : WGM;
        u.pm = fm + ((wgid % nig) % gsz); u.pn = (wgid % nig) / gsz; return true;
    }
    __device__ __forceinline__ void a_ready(const Unit&) const {}
    __device__ __forceinline__ void done(const Unit&) const {}
};

__device__ __forceinline__ unsigned cvt_pk_bf16(float lo, float hi) { unsigned r; asm volatile("v_cvt_pk_bf16_f32 %0, %1, %2" : "=v"(r) : "v"(lo), "v"(hi)); return r; }
__device__ __forceinline__ float silu_f(float v) { return v * __builtin_amdgcn_rcpf(1.0f + __expf(-v)); }
struct EpiSplit {
    static constexpr bool PERM = true, AFTER_DRAIN = false;
    bf16_t* O0; int ld0; int c1; bf16_t* O1; int ld1; int c2; float* O2; int ld2; bf16_t* halo;
    __device__ __forceinline__ void operator()(const f32x4 (&acc)[2][2][4][2], const Unit& u, int wr, int wc, int fr, int fq) const {
        const int row0 = u.pm * BM + wr * 64 + fr; const int colt = u.pn * BM;
        if (colt >= c2) {
            if (wc == 0) {
#pragma unroll
                for (int ai = 0; ai < 2; ++ai)
#pragma unroll
                    for (int m = 0; m < 4; ++m) { float* rp = O2 + (size_t)(row0 + ai * HALF + m * 16) * ld2 + 8 * fq; *(f32x4*)rp = acc[ai][0][m][0]; *(f32x4*)(rp + 4) = acc[ai][0][m][1]; }
            }
            return;
        }
        bf16_t* base; int ld, cb; bool hal = false;
        if (colt < c1) { base = O0; ld = ld0; cb = colt; } else { base = O1; ld = ld1; cb = colt - c1; hal = (halo != nullptr); }
        const int col0 = cb + wc * 32 + 8 * fq;
#pragma unroll
        for (int ai = 0; ai < 2; ++ai)
#pragma unroll
            for (int m = 0; m < 4; ++m) { const int r = row0 + ai * HALF + m * 16; bf16_t* rowp = base + (size_t)r * ld + col0;
#pragma unroll
                for (int bj = 0; bj < 2; ++bj) { const f32x4 v0 = acc[ai][bj][m][0], v1 = acc[ai][bj][m][1];
                    u32x4 w; w.x = cvt_pk_bf16(v0[0], v0[1]); w.y = cvt_pk_bf16(v0[2], v0[3]); w.z = cvt_pk_bf16(v1[0], v1[1]); w.w = cvt_pk_bf16(v1[2], v1[3]);
                    *(u32x4*)(rowp + bj * HALF) = w;
                    if (m == 3 && hal && fr >= 13) *(u32x4*)(halo + (size_t)((r >> 6) * 3 + (fr - 13)) * ld1 + col0 + bj * HALF) = w; } }
    }
};
struct EpiSwiGLU {
    static constexpr bool PERM = false, AFTER_DRAIN = false;
    bf16_t* H; int ldh;
    __device__ __forceinline__ void operator()(const f32x4 (&acc)[2][2][4][2], const Unit& u, int wr, int wc, int fr, int fq) const {
        const int row0 = u.pm * BM + wr * 64 + fr; const int hcol0 = (u.pn * BM + wc * 32) / 2 + 4 * fq;
        typedef unsigned u32x2v __attribute__((ext_vector_type(2)));
#pragma unroll
        for (int ai = 0; ai < 2; ++ai)
#pragma unroll
            for (int m = 0; m < 4; ++m) { bf16_t* rowp = H + (size_t)(row0 + ai * HALF + m * 16) * ldh + hcol0;
#pragma unroll
                for (int bj = 0; bj < 2; ++bj) { const f32x4 g = acc[ai][bj][m][0], up = acc[ai][bj][m][1];
                    u32x2v w; w.x = cvt_pk_bf16(silu_f(g[0]) * up[0], silu_f(g[1]) * up[1]); w.y = cvt_pk_bf16(silu_f(g[2]) * up[2], silu_f(g[3]) * up[3]);
                    *(u32x2v*)(rowp + bj * 64) = w; } }
    }
};
template <class Epi, class Sched, bool ALIGN_EPI = false, bool SP2 = false>
__device__ __forceinline__ void gemm_phase(PG8_LAS unsigned char* lds, const Gemm g, const Sched& S, const Epi& E) {
    const int tid = threadIdx.x, wid = __builtin_amdgcn_readfirstlane(tid >> 6), lane = tid & 63, wr = wid >> 2, wc = wid & 3, fr = lane & 15, fq = lane >> 4;
    const int K = g.K, nt = K / BK;
    unsigned voffA[2], voffB[2];
#pragma unroll
    for (int i = 0; i < 2; ++i) { int R, C; stage_rc(tid * 16 + i * 8192, R, C); const int Rb = Epi::PERM ? ((R & ~31) + perm32(R & 31)) : R;
        voffA[i] = (unsigned)(R * K + C) * 2u; voffB[i] = (unsigned)(Rb * K + C) * 2u; }
    const size_t kstep = (size_t)(BK * 2);
    const size_t hstep = (size_t)HALF * K * 2;
    const size_t tstep = 2 * hstep;
    const unsigned ldsw = (unsigned)wid * 1024u;
    const int aoff = lds_byte(wr * 64 + fr, fq * 8), boff = lds_byte(wc * 32 + fr, fq * 8);
#define PG8_SA(b, h) (((b) * 2 + (h)) * HTB)
#define PG8_SB(b, h) ((4 + (b) * 2 + (h)) * HTB)
#define PG8_STAGE(bufoff, gbase, voff) do { _Pragma("unroll") for (int _i = 0; _i < 2; ++_i) \
        __builtin_amdgcn_global_load_lds((const unsigned*)((const char*)(gbase) + (voff)[_i]), (PG8_LAS unsigned*)(lds + (bufoff) + ldsw + _i * 8192), 16, 0, 0); } while (0)
#define PG8_LDA(dst, b, h) do { _Pragma("unroll") for (int m = 0; m < 4; ++m) _Pragma("unroll") for (int k = 0; k < 2; ++k) dst[m][k] = *(const PG8_LAS bf16x8*)(lds + PG8_SA(b, h) + aoff + m * 2048 + k * 1024); } while (0)
#define PG8_LDB(dst, b, h) do { _Pragma("unroll") for (int n = 0; n < 2; ++n) _Pragma("unroll") for (int k = 0; k < 2; ++k) dst[n][k] = *(const PG8_LAS bf16x8*)(lds + PG8_SB(b, h) + boff + n * 2048 + k * 1024); } while (0)
#define PG8_MMA(ai, bj, At, Bt) do { __builtin_amdgcn_s_setprio(1); _Pragma("unroll") for (int m = 0; m < 4; ++m) _Pragma("unroll") for (int n = 0; n < 2; ++n) _Pragma("unroll") for (int k = 0; k < 2; ++k) \
        acc[ai][bj][m][n] = __builtin_amdgcn_mfma_f32_16x16x32_bf16(Bt[n][k], At[m][k], acc[ai][bj][m][n], 0, 0, 0); __builtin_amdgcn_s_setprio(0); } while (0)
#define PG8_WAIT_V(n) asm volatile("s_waitcnt vmcnt(" #n ")" ::: "memory")
#define PG8_WAIT_L(n) asm volatile("s_waitcnt lgkmcnt(" #n ")" ::: "memory")
#define PG8_BAR __builtin_amdgcn_s_barrier()
#define PG8_SCHED __builtin_amdgcn_sched_barrier(0)
    Unit cur, nxt; int ui = 0;
    if (!S.next(0, cur)) return;
    f32x4 acc[2][2][4][2];
#pragma unroll
    for (int a = 0; a < 2; ++a)
#pragma unroll
        for (int b = 0; b < 2; ++b)
#pragma unroll
            for (int m = 0; m < 4; ++m)
#pragma unroll
                for (int n = 0; n < 2; ++n) acc[a][b][m][n] = (f32x4){0.f, 0.f, 0.f, 0.f};
    bf16x8 At[4][2], B0[2][2], B1[2][2];
    const char* cA = (const char*)g.A + (size_t)cur.pm * tstep; const char* cB = (const char*)g.Bt + (size_t)cur.pn * tstep;
    S.a_ready(cur);
    if constexpr (SP2) {
        PG8_STAGE(PG8_SB(0, 0), cB, voffB); PG8_STAGE(PG8_SB(0, 1), cB + hstep, voffB); PG8_STAGE(PG8_SA(0, 0), cA, voffA); PG8_STAGE(PG8_SA(0, 1), cA + hstep, voffA);
        if (wr == 1) PG8_BAR;
        PG8_WAIT_V(2); PG8_BAR;
        PG8_STAGE(PG8_SB(1, 0), cB + kstep, voffB); PG8_STAGE(PG8_SA(1, 0), cA + kstep, voffA); PG8_STAGE(PG8_SB(1, 1), cB + hstep + kstep, voffB);
        PG8_WAIT_V(6); PG8_BAR;
    } else {
        PG8_STAGE(PG8_SB(0, 0), cB, voffB); PG8_STAGE(PG8_SA(0, 0), cA, voffA); PG8_STAGE(PG8_SB(0, 1), cB + hstep, voffB); PG8_STAGE(PG8_SA(0, 1), cA + hstep, voffA);
        if (wr == 1) PG8_BAR;
        PG8_WAIT_V(4); PG8_BAR;
        PG8_STAGE(PG8_SB(1, 0), cB + kstep, voffB); PG8_STAGE(PG8_SA(1, 0), cA + kstep, voffA); PG8_STAGE(PG8_SB(1, 1), cB + hstep + kstep, voffB);
        PG8_WAIT_V(6); PG8_BAR;
    }
    for (;;) {
        const bool has_next = S.next(ui + 1, nxt);
        const char* nA = has_next ? (const char*)g.A + (size_t)nxt.pm * tstep : cA; const char* nB = has_next ? (const char*)g.Bt + (size_t)nxt.pn * tstep : cB;
        for (int t = 0; t < nt; t += 2) {
            const bool last = (t == nt - 2);
            const char* a1 = cA + (size_t)(t + 1) * kstep;
            const char* a2 = last ? nA : cA + (size_t)(t + 2) * kstep; const char* b2 = last ? nB : cB + (size_t)(t + 2) * kstep;
            const char* a3 = a2 + kstep; const char* b3 = b2 + kstep;
            if (last && has_next) S.a_ready(nxt);
            if constexpr (SP2) {
            PG8_LDB(B0, 0, 0); PG8_LDB(B1, 0, 1); PG8_SCHED; PG8_LDA(At, 0, 0); PG8_STAGE(PG8_SA(1, 1), a1 + hstep, voffA);
            PG8_WAIT_V(8); PG8_WAIT_L(0); PG8_BAR; PG8_MMA(0, 0, At, B0); PG8_MMA(0, 1, At, B1); PG8_BAR; PG8_SCHED;
            PG8_LDA(At, 0, 1); PG8_STAGE(PG8_SB(0, 0), b2, voffB); PG8_STAGE(PG8_SB(0, 1), b2 + hstep, voffB); PG8_STAGE(PG8_SA(0, 0), a2, voffA);
            PG8_WAIT_V(8); PG8_WAIT_L(0); PG8_BAR; PG8_MMA(1, 0, At, B0); PG8_MMA(1, 1, At, B1); PG8_BAR; PG8_SCHED;
            PG8_LDB(B0, 1, 0); PG8_LDB(B1, 1, 1); PG8_SCHED; PG8_LDA(At, 1, 0); PG8_STAGE(PG8_SA(0, 1), a2 + hstep, voffA);
            PG8_WAIT_V(8); PG8_WAIT_L(0); PG8_BAR; PG8_MMA(0, 0, At, B0); PG8_MMA(0, 1, At, B1); PG8_BAR; PG8_SCHED;
            PG8_LDA(At, 1, 1); PG8_STAGE(PG8_SB(1, 0), b3, voffB); PG8_STAGE(PG8_SB(1, 1), b3 + hstep, voffB); PG8_STAGE(PG8_SA(1, 0), a3, voffA);
            PG8_WAIT_V(8); PG8_WAIT_L(0); PG8_BAR; PG8_MMA(1, 0, At, B0); PG8_MMA(1, 1, At, B1); PG8_BAR; PG8_SCHED;
            } else {
            PG8_LDB(B0, 0, 0); PG8_SCHED; PG8_LDA(At, 0, 0); PG8_STAGE(PG8_SA(1, 1), a1 + hstep, voffA);
            PG8_WAIT_L(8); PG8_BAR; PG8_WAIT_L(0); PG8_MMA(0, 0, At, B0); PG8_BAR; PG8_SCHED;
            PG8_LDB(B1, 0, 1); PG8_STAGE(PG8_SB(0, 0), b2, voffB);
            PG8_BAR; PG8_WAIT_L(0); PG8_MMA(0, 1, At, B1); PG8_BAR;
            PG8_LDA(At, 0, 1); PG8_STAGE(PG8_SA(0, 0), a2, voffA);
            PG8_BAR; PG8_WAIT_L(0); PG8_MMA(1, 0, At, B0); PG8_BAR; PG8_SCHED;
            PG8_STAGE(PG8_SB(0, 1), b2 + hstep, voffB);
            PG8_WAIT_V(6); PG8_BAR; PG8_MMA(1, 1, At, B1); PG8_BAR;
            PG8_LDB(B0, 1, 0); PG8_SCHED; PG8_LDA(At, 1, 0); PG8_STAGE(PG8_SA(0, 1), a2 + hstep, voffA);
            PG8_WAIT_L(8); PG8_BAR; PG8_WAIT_L(0); PG8_MMA(0, 0, At, B0); PG8_BAR; PG8_SCHED;
            PG8_LDB(B1, 1, 1); PG8_STAGE(PG8_SB(1, 0), b3, voffB);
            PG8_BAR; PG8_WAIT_L(0); PG8_MMA(0, 1, At, B1); PG8_BAR;
            PG8_LDA(At, 1, 1); PG8_STAGE(PG8_SA(1, 0), a3, voffA);
            PG8_BAR; PG8_WAIT_L(0); PG8_MMA(1, 0, At, B0); PG8_BAR; PG8_SCHED;
            PG8_STAGE(PG8_SB(1, 1), b3 + hstep, voffB);
            PG8_WAIT_V(6); PG8_BAR; PG8_MMA(1, 1, At, B1); PG8_BAR;
            }
        }
        if constexpr (ALIGN_EPI) { if (wr == 0) PG8_BAR; }
        if constexpr (!Epi::AFTER_DRAIN) { E(acc, cur, wr, wc, fr, fq); S.done(cur); }
        if (!has_next) break;
#pragma unroll
        for (int a = 0; a < 2; ++a)
#pragma unroll
            for (int b = 0; b < 2; ++b)
#pragma unroll
                for (int m = 0; m < 4; ++m)
#pragma unroll
                    for (int n = 0; n < 2; ++n) acc[a][b][m][n] = (f32x4){0.f, 0.f, 0.f, 0.f};
        cur = nxt; cA = nA; cB = nB; ++ui;
        if constexpr (ALIGN_EPI) { if (wr == 1) PG8_BAR; }
    }
    PG8_WAIT_V(0);
    if constexpr (!ALIGN_EPI) { if (wr == 0) PG8_BAR; }
    PG8_BAR;
    if constexpr (Epi::AFTER_DRAIN) { E.fused(acc, cur, wr, wc, fr, fq, lds, wid, lane); S.done(cur); }
#undef PG8_SA
#undef PG8_SB
#undef PG8_STAGE
#undef PG8_LDA
#undef PG8_LDB
#undef PG8_MMA
#undef PG8_WAIT_V
#undef PG8_WAIT_L
#undef PG8_BAR
#undef PG8_SCHED
}
}

#define LAS __attribute__((address_space(3)))
typedef unsigned short bf16;
typedef pg8::f32x4 f32x4;
typedef pg8::bf16x8 bf16x8;
typedef pg8::u32x4 u32x4;
typedef unsigned u32x2 __attribute__((ext_vector_type(2)));
typedef float f32x2 __attribute__((ext_vector_type(2)));

constexpr int NWAVES = 8, NTHR = 512;
constexpr int DM = 1024, MPR = 16384, MV = 16512, MPAD = 16640, SEQ = 8192;
constexpr int AB_IN = 2304, DFF = 2816, SSM_INP = 5376, SSM_INV = 5152, XBCW = 3072, ZW = 2048;
constexpr float EPS = 1e-6f;
constexpr size_t MiB = 1u << 20;
constexpr size_t WS_ROPE = 0, WS_BAR = 512 * 1024, BAR_BYTES = 16384;
constexpr size_t WS_W_ABIN = 1 * MiB, WS_W_ABOUT = WS_W_ABIN + 9 * MiB / 2, WS_W_UP0 = WS_W_ABOUT + 2 * MiB, WS_W_DN0 = WS_W_UP0 + 11 * MiB;
constexpr size_t WS_HALO = 1 * MiB, WS_DT = 6 * MiB, WS_SEG = 9 * MiB, WS_SEGD = 16 * MiB;
constexpr size_t WS_W_SSMIN = 24 * MiB, WS_W_SSMOUT = WS_W_SSMIN + 21 * MiB / 2, WS_W_UP1 = WS_W_SSMOUT + 4 * MiB, WS_W_DN1 = WS_W_UP1 + 11 * MiB;
constexpr size_t WS_XN = 55 * MiB;
constexpr size_t WS_P0 = 88 * MiB, WS_CAT = 162 * MiB, WS_MIX = 195 * MiB, WS_H = 88 * MiB, WS_Z = 88 * MiB, WS_XBC = 153 * MiB, WS_END = 256 * MiB;
static_assert(WS_W_DN0 + (size_t)DM * DFF * 2 <= 24 * MiB && WS_W_DN1 + (size_t)DM * DFF * 2 <= WS_XN && WS_XN + (size_t)MPAD * DM * 2 <= WS_P0, "ws map 1");
static_assert(WS_P0 + (size_t)MPAD * AB_IN * 2 <= WS_CAT && WS_CAT + (size_t)MPAD * DM * 2 <= WS_MIX && WS_MIX + (size_t)MPAD * DM * 2 <= WS_END, "ws map 2");
static_assert(WS_H + (size_t)MPAD * DFF * 2 <= WS_MIX && WS_Z + (size_t)MPAD * ZW * 2 <= WS_XBC && WS_XBC + (size_t)MPAD * XBCW * 2 <= WS_END, "ws map 3");
static_assert(WS_HALO + (size_t)260 * 3 * XBCW * 2 <= WS_DT && WS_DT + (size_t)MPAD * 32 * 4 <= WS_SEG && WS_SEG + (size_t)192 * 8192 * 4 <= WS_SEGD, "ws map 4");
constexpr size_t O_Y = 0, O_KP = 16908288, O_VP = O_KP + 32768, O_SCP = O_VP + 32768, O_CCP = O_SCP + 2048, O_SSP = O_CCP + 18432, O_KS = O_SSP + 524288, O_VS = O_KS + 16384,
                 O_SCS = O_VS + 16384, O_CCS = O_SCS + 8192, O_SSS = O_CCS + 73728, O_END = O_SSS + 2097152;
static_assert(O_END == 19730432, "output size");
constexpr int LDS_BYTES = 147456;

struct Args { const float* in[23]; float* out; unsigned char* ws; int ph_lo, ph_hi; };
enum { I_XP = 0, I_XS, I_CK, I_CV, I_SCONV, I_SSMCONV, I_SSM, I_NG, I_ABIN, I_ABOUT, I_SINK, I_SCW, I_SSMIN, I_SSMCW, I_SSMCB, I_DTB, I_ALOG, I_SSMD, I_SSMNG, I_SSMOUT, I_FG, I_FU, I_FD };

#define LDS_WAIT() asm volatile("s_waitcnt lgkmcnt(0)" ::: "memory")
__device__ __forceinline__ unsigned pk2(float lo, float hi) { return pg8::cvt_pk_bf16(lo, hi); }
__device__ __forceinline__ unsigned short f2bf(float f) { return (unsigned short)(pk2(f, 0.f) & 0xffffu); }
__device__ __forceinline__ float bflo(unsigned w) { return __builtin_bit_cast(float, w << 16); }
__device__ __forceinline__ float bfhi(unsigned w) { return __builtin_bit_cast(float, w & 0xffff0000u); }
__device__ __forceinline__ float bf1(unsigned short h) { return __builtin_bit_cast(float, (unsigned)h << 16); }
__device__ __forceinline__ void unpack8(const u32x4 w, float (&f)[8]) { f[0] = bflo(w.x); f[1] = bfhi(w.x); f[2] = bflo(w.y); f[3] = bfhi(w.y); f[4] = bflo(w.z); f[5] = bfhi(w.z); f[6] = bflo(w.w); f[7] = bfhi(w.w); }
__device__ __forceinline__ u32x4 pack8(const float (&f)[8]) { u32x4 w; w.x = pk2(f[0], f[1]); w.y = pk2(f[2], f[3]); w.z = pk2(f[4], f[5]); w.w = pk2(f[6], f[7]); return w; }
__device__ __forceinline__ float wave_sum(float v) {
#pragma unroll
    for (int o = 1; o < 64; o <<= 1) v += __shfl_xor(v, o);
    return v;
}
__device__ __forceinline__ float silu(float v) { return v * __builtin_amdgcn_rcpf(1.0f + __expf(-v)); }
__device__ __forceinline__ f32x4 mfma16(bf16x8 a, bf16x8 b, f32x4 c) { return __builtin_amdgcn_mfma_f32_16x16x32_bf16(a, b, c, 0, 0, 0); }

__device__ __forceinline__ void transpose_item(const float* W, int K, int N, bf16* WT, int mode, LAS float* scr, int item, int lane) {
    const int nblk = N / 32, kb = item / nblk, nb = item % nblk, k0 = 64 * kb, n0 = 32 * nb;
#pragma unroll 8
    for (int i = 0; i < 32; ++i) { const int kk = 2 * i + (lane >> 5); scr[kk * 33 + (lane & 31)] = W[(size_t)(k0 + kk) * N + n0 + (lane & 31)]; }
    LDS_WAIT(); asm volatile("" ::: "memory");
    const int c = lane & 7;
#pragma unroll
    for (int j = 0; j < 4; ++j) { const int n = (lane >> 3) + 8 * j; const LAS float* s = scr + (8 * c) * 33 + n; const int cn = n0 + n;
        const int drow = (mode == 0) ? cn : (((cn >> 4) << 5) + (cn & 15) + (mode == 2 ? 16 : 0));
        u32x4 o; o.x = pk2(s[0 * 33], s[1 * 33]); o.y = pk2(s[2 * 33], s[3 * 33]); o.z = pk2(s[4 * 33], s[5 * 33]); o.w = pk2(s[6 * 33], s[7 * 33]);
        *(u32x4*)(WT + (size_t)drow * K + k0 + 8 * c) = o; }
    LDS_WAIT(); asm volatile("" ::: "memory");
}
__device__ __forceinline__ void p0_prologue(const Args& a, LAS unsigned char* lds, int G, int bid) {
    const int tid = threadIdx.x, lane = tid & 63, wave = tid >> 6;
    unsigned char* ws = a.ws;
    LAS float* scr = (LAS float*)(lds + wave * 16384);
    const int gw = bid * NWAVES + wave, NGW = G * NWAVES;
    constexpr int I_1 = 16 * 72, I_2 = 16 * 32, I_F = 16 * 88, I_D = 44 * 32, I_5 = 16 * 161, I_6 = 32 * 32;
    constexpr int NITEMS = I_1 + I_2 + 4 * I_F + 2 * I_D + I_5 + I_6;
    for (int it = gw; it < NITEMS; it += NGW) {
        int r = it;
        if (r < I_5) { transpose_item(a.in[I_SSMIN], DM, SSM_INV, (bf16*)(ws + WS_W_SSMIN), 0, scr, r, lane); continue; } r -= I_5;
        if (r < I_1) { transpose_item(a.in[I_ABIN], DM, AB_IN, (bf16*)(ws + WS_W_ABIN), 0, scr, r, lane); continue; } r -= I_1;
        if (r < I_2) { transpose_item(a.in[I_ABOUT], DM, DM, (bf16*)(ws + WS_W_ABOUT), 0, scr, r, lane); continue; } r -= I_2;
        if (r < I_F) { transpose_item(a.in[I_FG], DM, DFF, (bf16*)(ws + WS_W_UP0), 1, scr, r, lane); continue; } r -= I_F;
        if (r < I_F) { transpose_item(a.in[I_FU], DM, DFF, (bf16*)(ws + WS_W_UP0), 2, scr, r, lane); continue; } r -= I_F;
        if (r < I_D) { transpose_item(a.in[I_FD], DFF, DM, (bf16*)(ws + WS_W_DN0), 0, scr, r, lane); continue; } r -= I_D;
        if (r < I_6) { transpose_item(a.in[I_SSMOUT], ZW, DM, (bf16*)(ws + WS_W_SSMOUT), 0, scr, r, lane); continue; } r -= I_6;
        if (r < I_F) { transpose_item(a.in[I_FG] + (size_t)DM * DFF, DM, DFF, (bf16*)(ws + WS_W_UP1), 1, scr, r, lane); continue; } r -= I_F;
        if (r < I_F) { transpose_item(a.in[I_FU] + (size_t)DM * DFF, DM, DFF, (bf16*)(ws + WS_W_UP1), 2, scr, r, lane); continue; } r -= I_F;
        transpose_item(a.in[I_FD] + (size_t)DM * DFF, DFF, DM, (bf16*)(ws + WS_W_DN1), 0, scr, r, lane);
    }
    const int gt = bid * NTHR + tid, NGT = G * NTHR;
    { u32x4 z = (u32x4){0u, 0u, 0u, 0u};
      u32x4* p1 = (u32x4*)((bf16*)(ws + WS_W_SSMIN) + (size_t)SSM_INV * DM); for (int i = gt; i < (SSM_INP - SSM_INV) * DM / 8; i += NGT) p1[i] = z;
      u32x4* p2 = (u32x4*)((bf16*)(ws + WS_XN) + (size_t)MV * DM); for (int i = gt; i < (MPAD - MV) * DM / 8; i += NGT) p2[i] = z; }
    { f32x2* rope = (f32x2*)(ws + WS_ROPE);
      for (int i = gt; i < SEQ * 8; i += NGT) { const int pos = i >> 3, k = i & 7;
          const double invf = k == 0 ? 1.0 : k == 1 ? 0.19392274474868576 : k == 2 ? 0.03760603093086393 : k == 3 ? 0.007292664737217109 : k == 4 ? 0.001414213562373095 : k == 5 ? 0.0002742481756762073 : k == 6 ? 5.318295896944988e-05 : 1.031338537721246e-05;
          const double rev = (double)pos * invf * 0.15915494309189535; const float fr = (float)(rev - __builtin_floor(rev));
          rope[i] = (f32x2){__builtin_amdgcn_cosf(fr), __builtin_amdgcn_sinf(fr)}; } }
    const f32x4* g4 = (const f32x4*)(a.in[I_NG]);
    for (int row = gw; row < MV; row += NGW) {
        const f32x4* src = (const f32x4*)(row < MPR ? a.in[I_XP] + (size_t)row * DM : a.in[I_XS] + (size_t)(row - MPR) * DM);
        f32x4* dst = (f32x4*)(a.out + (size_t)row * DM);
        f32x4 v[4]; float ss = 0.f;
#pragma unroll
        for (int j = 0; j < 4; ++j) { v[j] = src[lane + 64 * j]; ss += (v[j].x * v[j].x + v[j].y * v[j].y) + (v[j].z * v[j].z + v[j].w * v[j].w); dst[lane + 64 * j] = v[j]; }
        const float r = __builtin_amdgcn_rsqf(wave_sum(ss) * (1.f / DM) + EPS);
        u32x2* o = (u32x2*)((bf16*)(ws + WS_XN) + (size_t)row * DM);
#pragma unroll
        for (int j = 0; j < 4; ++j) { const f32x4 g = g4[lane + 64 * j]; u32x2 w; w.x = pk2(v[j].x * r * g.x, v[j].y * r * g.y); w.y = pk2(v[j].z * r * g.z, v[j].w * r * g.w); o[lane + 64 * j] = w; }
    }
}
template <bool SECOND>
__device__ __forceinline__ void nrn_rows(const Args& a, const float* g1, const float* g2, int G, int bid) {
    const int tid = threadIdx.x, lane = tid & 63, wave = tid >> 6;
    const int gw = bid * NWAVES + wave, NGW = G * NWAVES;
    const bf16* mix = (const bf16*)(a.ws + WS_MIX); bf16* xn = (bf16*)(a.ws + WS_XN);
    const f32x4* g14 = (const f32x4*)g1; const f32x4* g24 = (const f32x4*)g2;
    for (int row = gw; row < MV; row += NGW) {
        const u32x2* mp = (const u32x2*)(mix + (size_t)row * DM);
        f32x4* xp = (f32x4*)(a.out + (size_t)row * DM);
        f32x4 m[4], xv[4]; float ss = 0.f;
#pragma unroll
        for (int j = 0; j < 4; ++j) { const u32x2 w = mp[lane + 64 * j]; m[j] = (f32x4){bflo(w.x), bfhi(w.x), bflo(w.y), bfhi(w.y)}; xv[j] = xp[lane + 64 * j];
            ss += (m[j].x * m[j].x + m[j].y * m[j].y) + (m[j].z * m[j].z + m[j].w * m[j].w); }
        const float r1 = __builtin_amdgcn_rsqf(wave_sum(ss) * (1.f / DM) + EPS);
        float s2 = 0.f;
#pragma unroll
        for (int j = 0; j < 4; ++j) { const f32x4 g = g14[lane + 64 * j]; xv[j] = xv[j] + m[j] * r1 * g; xp[lane + 64 * j] = xv[j];
            s2 += (xv[j].x * xv[j].x + xv[j].y * xv[j].y) + (xv[j].z * xv[j].z + xv[j].w * xv[j].w); }
        if (SECOND) {
            const float r2 = __builtin_amdgcn_rsqf(wave_sum(s2) * (1.f / DM) + EPS);
            u32x2* o = (u32x2*)(xn + (size_t)row * DM);
#pragma unroll
            for (int j = 0; j < 4; ++j) { const f32x4 g = g24[lane + 64 * j]; u32x2 w; w.x = pk2(xv[j].x * r2 * g.x, xv[j].y * r2 * g.y); w.y = pk2(xv[j].z * r2 * g.z, xv[j].w * r2 * g.w); o[lane + 64 * j] = w; }
        }
    }
}

__device__ __forceinline__ void load8_rope(const bf16* hp, int dg, const f32x2* rp, float (&o)[8]) {
    const u32x4 w = *(const u32x4*)(hp + dg * 8); unpack8(w, o);
    if (dg < 2) { float p[8]; const u32x4 w2 = *(const u32x4*)(hp + (1 - dg) * 8); unpack8(w2, p);
#pragma unroll
        for (int j = 0; j < 8; ++j) { const f32x2 cs = rp[j]; o[j] = dg == 0 ? o[j] * cs.x - p[j] * cs.y : o[j] * cs.x + p[j] * cs.y; } }
}
__device__ __forceinline__ void attn_phase(const Args& a, LAS unsigned char* lds, int G, int bid) {
    LAS bf16* Qs = (LAS bf16*)lds;
    LAS bf16* Ks = (LAS bf16*)(lds + 36864);
    LAS bf16* Vt = (LAS bf16*)(lds + 64512);
    const int tid = threadIdx.x, lane = tid & 63, w = tid >> 6, fr = lane & 15, fq = lane >> 4;
    const bf16* P0 = (const bf16*)(a.ws + WS_P0); bf16* CAT = (bf16*)(a.ws + WS_CAT);
    const f32x2* rope = (const f32x2*)(a.ws + WS_ROPE);
    for (int u = bid; u < 528; u += G) {
        const bool smp = u >= 512;
        int b, c = 0, kvh, nq, nkc = 0, nvalid, qrow0;
        if (!smp) { kvh = u & 1; c = (u >> 1) & 127; b = u >> 8; nq = 64; nkc = (c < 2 ? c : 2) + 1; nvalid = 64 * nkc; qrow0 = b * SEQ + c * 64; }
        else { const int v = u - 512; kvh = v & 1; b = v >> 1; nq = 16; nvalid = 144; qrow0 = MPR + b * 16; }
#pragma unroll
        for (int it = 0; it < 4; ++it) { const int item = tid + NTHR * it, q = item >> 3, dg = item & 7, hh = q >> 6, i = q & 63;
            u32x4 o = (u32x4){0u, 0u, 0u, 0u};
            if (i < nq) { const int pos = smp ? 4096 + i : c * 64 + i; float f[8]; load8_rope(P0 + (size_t)(qrow0 + i) * AB_IN + (4 * kvh + hh) * 64, dg, rope + pos * 8, f);
#pragma unroll
                for (int j = 0; j < 8; ++j) f[j] *= 0.125f;
                o = pack8(f); }
            *(LAS u32x4*)(Qs + q * 72 + dg * 8) = o; }
#pragma unroll
        for (int it = 0; it < 3; ++it) { const int kr = lane + 64 * it, dg = w;
            u32x4 ko = (u32x4){0u, 0u, 0u, 0u}, vo = ko;
            if (kr < nvalid) {
                if (smp && kr < 128) { const size_t off = ((size_t)(b * 128 + kr) * 2 + kvh) * 64 + dg * 8;
                    const f32x4 k0 = *(const f32x4*)(a.in[I_CK] + off), k1 = *(const f32x4*)(a.in[I_CK] + off + 4), v0 = *(const f32x4*)(a.in[I_CV] + off), v1 = *(const f32x4*)(a.in[I_CV] + off + 4);
                    ko.x = pk2(k0.x, k0.y); ko.y = pk2(k0.z, k0.w); ko.z = pk2(k1.x, k1.y); ko.w = pk2(k1.z, k1.w); vo.x = pk2(v0.x, v0.y); vo.y = pk2(v0.z, v0.w); vo.z = pk2(v1.x, v1.y); vo.w = pk2(v1.z, v1.w); }
                else { int row, pos; if (smp) { row = MPR + b * 16 + (kr - 128); pos = 4096 + kr - 128; } else { pos = (c - nkc + 1 + (kr >> 6)) * 64 + (kr & 63); row = b * SEQ + pos; }
                    const bf16* rp = P0 + (size_t)row * AB_IN; float f[8]; load8_rope(rp + 512 + kvh * 64, dg, rope + pos * 8, f); ko = pack8(f);
                    vo = *(const u32x4*)(rp + 640 + kvh * 64 + dg * 8); }
            }
            *(LAS u32x4*)(Ks + kr * 72 + dg * 8) = ko;
            LAS bf16* vp = Vt + (dg * 8) * 200 + kr;
            vp[0 * 200] = (bf16)(vo.x & 0xffffu); vp[1 * 200] = (bf16)(vo.x >> 16); vp[2 * 200] = (bf16)(vo.y & 0xffffu); vp[3 * 200] = (bf16)(vo.y >> 16);
            vp[4 * 200] = (bf16)(vo.z & 0xffffu); vp[5 * 200] = (bf16)(vo.z >> 16); vp[6 * 200] = (bf16)(vo.w & 0xffffu); vp[7 * 200] = (bf16)(vo.w >> 16); }
        __syncthreads();
        const int hh = w >> 1, qh = w & 1;
        if (qh * 32 < nq) {
            f32x4 s[12][2];
#pragma unroll
            for (int kt = 0; kt < 12; ++kt) { s[kt][0] = (f32x4){0.f, 0.f, 0.f, 0.f}; s[kt][1] = s[kt][0]; }
#pragma unroll
            for (int ks = 0; ks < 2; ++ks) {
                bf16x8 bq[2];
#pragma unroll
                for (int qt = 0; qt < 2; ++qt) bq[qt] = *(const LAS bf16x8*)(Qs + (w * 32 + qt * 16 + fr) * 72 + ks * 32 + fq * 8);
#pragma unroll
                for (int kt = 0; kt < 12; ++kt) if (kt * 16 < nvalid) { const bf16x8 ak = *(const LAS bf16x8*)(Ks + (kt * 16 + fr) * 72 + ks * 32 + fq * 8);
                    s[kt][0] = mfma16(ak, bq[0], s[kt][0]); s[kt][1] = mfma16(ak, bq[1], s[kt][1]); }
            }
            const float sink = a.in[I_SINK][4 * kvh + hh];
            float inv[2];
#pragma unroll
            for (int qt = 0; qt < 2; ++qt) {
                float m = sink;
#pragma unroll
                for (int kt = 0; kt < 12; ++kt) if (kt * 16 < nvalid) m = fmaxf(fmaxf(m, fmaxf(s[kt][qt][0], s[kt][qt][1])), fmaxf(s[kt][qt][2], s[kt][qt][3]));
                m = fmaxf(m, __shfl_xor(m, 16)); m = fmaxf(m, __shfl_xor(m, 32));
                float sum = 0.f;
#pragma unroll
                for (int kt = 0; kt < 12; ++kt) { if (kt * 16 < nvalid) {
#pragma unroll
                        for (int i = 0; i < 4; ++i) { const float p = __expf(s[kt][qt][i] - m); s[kt][qt][i] = p; sum += p; } }
                    else s[kt][qt] = (f32x4){0.f, 0.f, 0.f, 0.f}; }
                sum += __shfl_xor(sum, 16); sum += __shfl_xor(sum, 32);
                inv[qt] = 1.0f / (sum + __expf(sink - m));
            }
            f32x4 o[4][2];
#pragma unroll
            for (int dt = 0; dt < 4; ++dt) { o[dt][0] = (f32x4){0.f, 0.f, 0.f, 0.f}; o[dt][1] = o[dt][0]; }
#pragma unroll
            for (int kk = 0; kk < 6; ++kk) if (kk * 32 < nvalid) {
                bf16x8 bp[2];
#pragma unroll
                for (int qt = 0; qt < 2; ++qt) { u32x4 t; t.x = pk2(s[2 * kk][qt][0], s[2 * kk][qt][1]); t.y = pk2(s[2 * kk][qt][2], s[2 * kk][qt][3]); t.z = pk2(s[2 * kk + 1][qt][0], s[2 * kk + 1][qt][1]); t.w = pk2(s[2 * kk + 1][qt][2], s[2 * kk + 1][qt][3]);
                    bp[qt] = __builtin_bit_cast(bf16x8, t); }
#pragma unroll
                for (int dt = 0; dt < 4; ++dt) { const LAS bf16* vp = Vt + (dt * 16 + fr) * 200 + kk * 32 + 4 * fq;
                    const u32x2 lo = *(const LAS u32x2*)vp, hi = *(const LAS u32x2*)(vp + 16); const u32x4 t = (u32x4){lo.x, lo.y, hi.x, hi.y}; const bf16x8 av = __builtin_bit_cast(bf16x8, t);
                    o[dt][0] = mfma16(av, bp[0], o[dt][0]); o[dt][1] = mfma16(av, bp[1], o[dt][1]); }
            }
#pragma unroll
            for (int qt = 0; qt < 2; ++qt) { const int tok = qh * 32 + qt * 16 + fr;
                if (tok < nq) { bf16* op = CAT + (size_t)(qrow0 + tok) * DM + (4 * kvh + hh) * 64 + 4 * fq;
#pragma unroll
                    for (int dt = 0; dt < 4; ++dt) { const f32x4 v = o[dt][qt] * inv[qt]; u32x2 wv; wv.x = pk2(v[0], v[1]); wv.y = pk2(v[2], v[3]); *(u32x2*)(op + dt * 16) = wv; } } }
        }
        __syncthreads();
    }
    const int gt = bid * NTHR + tid, NGT = G * NTHR;
    const float* scw = a.in[I_SCW];
    for (int it = gt; it < MV * 64; it += NGT) { const int row = it >> 6, ch = (it & 63) * 8;
        int t, L, bb; if (row < MPR) { bb = row >> 13; t = row & (SEQ - 1); L = SEQ; } else { bb = (row - MPR) >> 4; t = (row - MPR) & 15; L = 16; }
        float acc[8], uc[8];
#pragma unroll
        for (int j = 0; j < 8; ++j) acc[j] = 0.f;
#pragma unroll
        for (int d = 0; d < 3; ++d) {
            const int tt = t - 2 + d; float uu[8];
            if (tt >= 0) { const bf16* rp = P0 + (size_t)(row - 2 + d) * AB_IN; float gc[8], hx[8]; unpack8(*(const u32x4*)(rp + 1280 + ch), gc); unpack8(*(const u32x4*)(rp + 1792 + ch), hx);
#pragma unroll
                for (int j = 0; j < 8; ++j) uu[j] = gc[j] * hx[j]; }
            else if (row >= MPR) { const float* hp = a.in[I_SCONV] + ((size_t)bb * 2 + (2 + tt)) * 512 + ch;
#pragma unroll
                for (int j = 0; j < 8; ++j) uu[j] = hp[j]; }
            else {
#pragma unroll
                for (int j = 0; j < 8; ++j) uu[j] = 0.f; }
#pragma unroll
            for (int j = 0; j < 8; ++j) { acc[j] += scw[d * 512 + ch + j] * uu[j]; if (d == 2) uc[j] = uu[j]; }
        }
        float gb[8]; unpack8(*(const u32x4*)(P0 + (size_t)row * AB_IN + 768 + ch), gb);
#pragma unroll
        for (int j = 0; j < 8; ++j) acc[j] *= gb[j];
        *(u32x4*)(CAT + (size_t)row * DM + 512 + ch) = pack8(acc);
        if (t >= L - 2) { float* op = a.out + (row < MPR ? O_SCP + ((size_t)bb * 2 + (t - (L - 2))) * 512 : O_SCS + ((size_t)bb * 2 + (t - (L - 2))) * 512) + ch;
#pragma unroll
            for (int j = 0; j < 8; ++j) op[j] = uc[j]; }
    }
    for (int it = gt; it < (256 + 128) * 32; it += NGT) { const int ri = it >> 5, kvh = (it >> 4) & 1, dg = (it >> 1) & 7, isv = it & 1;
        int row, pos; float* op;
        if (ri < 256) { const int bb = ri >> 7, j = ri & 127; pos = SEQ - 128 + j; row = bb * SEQ + pos; op = a.out + (isv ? O_VP : O_KP) + ((size_t)(bb * 128 + j) * 2 + kvh) * 64 + dg * 8; }
        else { const int r2 = ri - 256, bb = r2 >> 4, j = r2 & 15; pos = 4096 + j; row = MPR + r2; op = a.out + (isv ? O_VS : O_KS) + ((size_t)(bb * 16 + j) * 2 + kvh) * 64 + dg * 8; }
        const bf16* rp = P0 + (size_t)row * AB_IN; float f[8];
        if (isv) unpack8(*(const u32x4*)(rp + 640 + kvh * 64 + dg * 8), f); else load8_rope(rp + 512 + kvh * 64, dg, rope + pos * 8, f);
        *(f32x4*)op = (f32x4){f[0], f[1], f[2], f[3]}; *(f32x4*)(op + 4) = (f32x4){f[4], f[5], f[6], f[7]};
    }
}

__device__ __forceinline__ void ssmconv_phase(const Args& a, int G, int bid) {
    const int tid = threadIdx.x, gt = bid * NTHR + tid, NGT = G * NTHR;
    bf16* XBC = (bf16*)(a.ws + WS_XBC); const bf16* HALO = (const bf16*)(a.ws + WS_HALO);
    const float* cw = a.in[I_SSMCW]; const float* cb = a.in[I_SSMCB];
    for (int it = gt; it < 264 * 384; it += NGT) {
        int cgp, r0, nrows; const bf16* hal = nullptr; const float* hist = nullptr; float* outc = nullptr;
        if (it < 256 * 384) { const int blk = it / 384; cgp = it - blk * 384; r0 = blk * 64; nrows = 64; if (blk & 127) hal = HALO + (size_t)(blk - 1) * 3 * XBCW; if ((blk & 127) == 127) outc = a.out + O_CCP + (size_t)(blk >> 7) * 3 * XBCW; }
        else { const int v = it - 256 * 384, bs = v / 384; cgp = v - bs * 384; r0 = MPR + bs * 16; nrows = 16; hist = a.in[I_SSMCONV] + (size_t)bs * 3 * XBCW; outc = a.out + O_CCS + (size_t)bs * 3 * XBCW; }
        const int col = cgp * 8;
        float h0[8], h1[8], h2[8], w0[8], w1[8], w2[8], w3[8], bz[8];
#pragma unroll
        for (int j = 0; j < 8; ++j) { h0[j] = 0.f; h1[j] = 0.f; h2[j] = 0.f; w0[j] = cw[col + j]; w1[j] = cw[XBCW + col + j]; w2[j] = cw[2 * XBCW + col + j]; w3[j] = cw[3 * XBCW + col + j]; bz[j] = cb[col + j]; }
        if (hal) { unpack8(*(const u32x4*)(hal + col), h0); unpack8(*(const u32x4*)(hal + XBCW + col), h1); unpack8(*(const u32x4*)(hal + 2 * XBCW + col), h2); }
        if (hist) {
#pragma unroll
            for (int j = 0; j < 8; ++j) { h0[j] = hist[col + j]; h1[j] = hist[XBCW + col + j]; h2[j] = hist[2 * XBCW + col + j]; } }
        bf16* p = XBC + (size_t)r0 * XBCW + col;
        for (int r = 0; r < nrows; r += 4) {
            u32x4 raw[4];
#pragma unroll
            for (int q = 0; q < 4; ++q) raw[q] = *(const u32x4*)(p + (size_t)(r + q) * XBCW);
#pragma unroll
            for (int q = 0; q < 4; ++q) { float cur[8], y[8]; unpack8(raw[q], cur);
#pragma unroll
                for (int j = 0; j < 8; ++j) { y[j] = silu(w0[j] * h0[j] + w1[j] * h1[j] + w2[j] * h2[j] + w3[j] * cur[j] + bz[j]); h0[j] = h1[j]; h1[j] = h2[j]; h2[j] = cur[j]; }
                *(u32x4*)(p + (size_t)(r + q) * XBCW) = pack8(y); }
        }
        if (outc) {
#pragma unroll
            for (int j = 0; j < 8; ++j) { outc[col + j] = h0[j]; outc[XBCW + col + j] = h1[j]; outc[2 * XBCW + col + j] = h2[j]; } }
    }
    float* DT = (float*)(a.ws + WS_DT); const float* dtb = a.in[I_DTB];
    for (int it = gt; it < MV * 32; it += NGT) { const float x = DT[it] + dtb[it & 31]; const float e = __expf(x);
        DT[it] = x > 20.f ? x : (e < 1e-2f ? e * (1.f - e * (0.5f - e * 0.33333333f)) : __logf(1.f + e)); }
}

constexpr int S_XT = 0, S_XW = 9216, S_BM = 18432, S_BT = 35840, S_CM = 54272, S_HA = 71680, S_SC = 89088;
template <bool FULL>
__device__ __forceinline__ void ssd_stream(const Args& a, LAS unsigned char* lds, f32x4 (&st)[2][2], const int row0, const int nchunks, const int nvalid, const int h, const float a_h, const float d_h, float& logdec) {
    LAS bf16* xT = (LAS bf16*)(lds + S_XT); LAS bf16* xwT = (LAS bf16*)(lds + S_XW); LAS bf16* Bm = (LAS bf16*)(lds + S_BM); LAS bf16* BT = (LAS bf16*)(lds + S_BT);
    LAS bf16* Cm = (LAS bf16*)(lds + S_CM); LAS bf16* HA = (LAS bf16*)(lds + S_HA); LAS float* scal0 = (LAS float*)(lds + S_SC);
    const int tid = threadIdx.x, lane = tid & 63, w = tid >> 6, fr = lane & 15, fq = lane >> 4, nq4 = w & 3, pr = w >> 2, g = h >> 3, lt = w & 3;
    const bf16* XBC = (const bf16*)(a.ws + WS_XBC); bf16* Z = (bf16*)(a.ws + WS_Z); const float* DT = (const float*)(a.ws + WS_DT);
    u32x4 px, pb[2], pc[2]; float pdt = 0.f;
    const u32x4 zero4 = (u32x4){0u, 0u, 0u, 0u};
    const bool lv = lane < nvalid;
#define SSD_PREFETCH(ci) do { const bf16* rp_ = XBC + (size_t)(row0 + 64 * (ci) + lane) * XBCW; \
        px = lv ? *(const u32x4*)(rp_ + h * 64 + w * 8) : zero4; \
        _Pragma("unroll") for (int k_ = 0; k_ < 2; ++k_) { pb[k_] = lv ? *(const u32x4*)(rp_ + 2048 + g * 128 + (w + 8 * k_) * 8) : zero4; \
            if (FULL) pc[k_] = lv ? *(const u32x4*)(rp_ + 2560 + g * 128 + (w + 8 * k_) * 8) : zero4; } } while (0)
#define SSD_DTLOAD(ci) do { pdt = (lv && (ci) < nchunks) ? DT[(size_t)(row0 + 64 * (ci) + lane) * 32 + h] : 0.f; } while (0)
#define SSD_SCAN(buf) do { LAS float* sc_ = scal0 + 320 * (buf); const float dtl_ = pdt; float v_ = dtl_ * a_h; \
        _Pragma("unroll") for (int o_ = 1; o_ < 64; o_ <<= 1) { const float t_ = __shfl_up(v_, o_); if (lane >= o_) v_ += t_; } \
        const float tot_ = __shfl(v_, 63); sc_[lane] = v_; sc_[64 + lane] = __expf(v_); sc_[128 + lane] = __expf(tot_ - v_) * dtl_; sc_[192 + lane] = dtl_; if (lane == 0) sc_[256] = tot_; } while (0)
    SSD_PREFETCH(0);
    if (w == 0) { SSD_DTLOAD(0); SSD_SCAN(0); SSD_DTLOAD(1); }
    __syncthreads();
    for (int ci = 0; ci < nchunks; ++ci) {
        const int rbase = row0 + 64 * ci;
        LAS float* scal = scal0 + 320 * (ci & 1);
        { const float dte = scal[128 + lane]; float f[8]; unpack8(px, f);
          LAS bf16* p1 = xT + (w * 8) * 72 + lane; LAS bf16* p2 = xwT + (w * 8) * 72 + lane;
#pragma unroll
          for (int j = 0; j < 8; ++j) { p1[j * 72] = f2bf(f[j]); p2[j * 72] = f2bf(f[j] * dte); } }
#pragma unroll
        for (int k = 0; k < 2; ++k) { const int ng = w + 8 * k;
            *(LAS u32x4*)(Bm + lane * 136 + ng * 8) = pb[k];
            LAS bf16* bp = BT + (ng * 8) * 72 + lane; const u32x4 v = pb[k];
            bp[0 * 72] = (bf16)(v.x & 0xffffu); bp[1 * 72] = (bf16)(v.x >> 16); bp[2 * 72] = (bf16)(v.y & 0xffffu); bp[3 * 72] = (bf16)(v.y >> 16);
            bp[4 * 72] = (bf16)(v.z & 0xffffu); bp[5 * 72] = (bf16)(v.z >> 16); bp[6 * 72] = (bf16)(v.w & 0xffffu); bp[7 * 72] = (bf16)(v.w >> 16);
            if (FULL) *(LAS u32x4*)(Cm + lane * 136 + ng * 8) = pc[k]; }
        if (FULL) {
#pragma unroll
            for (int nt = 0; nt < 2; ++nt)
#pragma unroll
                for (int pt = 0; pt < 2; ++pt) { const f32x4 v = st[nt][pt]; u32x2 wv; wv.x = pk2(v[0], v[1]); wv.y = pk2(v[2], v[3]);
                    *(LAS u32x2*)(HA + (32 * pr + 16 * pt + fr) * 136 + 32 * nq4 + 16 * nt + 4 * fq) = wv; } }
        if (ci + 1 < nchunks) SSD_PREFETCH(ci + 1);
        __syncthreads();
        if (w == 0 && ci + 1 < nchunks) { SSD_SCAN((ci + 1) & 1); SSD_DTLOAD(ci + 2); }
        u32x2 zr[2]; const int l = 16 * lt + fr;
        if (FULL) {
#pragma unroll
            for (int k2 = 0; k2 < 2; ++k2) { zr[k2] = (u32x2){0u, 0u}; if (l < nvalid) zr[k2] = *(const u32x2*)(Z + (size_t)(rbase + l) * ZW + h * 64 + 16 * (2 * pr + k2) + 4 * fq); } }
        { const float tot = scal[256]; logdec += tot; const float dec = __expf(tot);
#pragma unroll
          for (int nt = 0; nt < 2; ++nt)
#pragma unroll
              for (int pt = 0; pt < 2; ++pt) st[nt][pt] = st[nt][pt] * dec;
#pragma unroll
          for (int ks = 0; ks < 2; ++ks) { bf16x8 af[2], bx[2];
#pragma unroll
              for (int t = 0; t < 2; ++t) { af[t] = *(const LAS bf16x8*)(BT + (32 * nq4 + 16 * t + fr) * 72 + ks * 32 + fq * 8); bx[t] = *(const LAS bf16x8*)(xwT + (32 * pr + 16 * t + fr) * 72 + ks * 32 + fq * 8); }
#pragma unroll
              for (int nt = 0; nt < 2; ++nt)
#pragma unroll
                  for (int pt = 0; pt < 2; ++pt) st[nt][pt] = mfma16(af[nt], bx[pt], st[nt][pt]); } }
        if (FULL) {
            bf16x8 cf[4];
#pragma unroll
            for (int ks = 0; ks < 4; ++ks) cf[ks] = *(const LAS bf16x8*)(Cm + l * 136 + ks * 32 + fq * 8);
            const float al = scal[l];
            unsigned wpk[4][2];
#pragma unroll
            for (int s4 = 0; s4 < 4; ++s4) {
                wpk[s4][0] = 0u; wpk[s4][1] = 0u;
                if (s4 <= lt) { f32x4 acc = (f32x4){0.f, 0.f, 0.f, 0.f};
#pragma unroll
                    for (int ks = 0; ks < 4; ++ks) { const bf16x8 af = *(const LAS bf16x8*)(Bm + (16 * s4 + fr) * 136 + ks * 32 + fq * 8); acc = mfma16(af, cf[ks], acc); }
                    const f32x4 as = *(const LAS f32x4*)(scal + 16 * s4 + 4 * fq), ds = *(const LAS f32x4*)(scal + 192 + 16 * s4 + 4 * fq); float v[4];
#pragma unroll
                    for (int i = 0; i < 4; ++i) { const int s = 16 * s4 + 4 * fq + i; v[i] = s <= l ? acc[i] * __expf(al - as[i]) * ds[i] : 0.f; }
                    wpk[s4][0] = pk2(v[0], v[1]); wpk[s4][1] = pk2(v[2], v[3]); }
            }
            bf16x8 bw[2];
#pragma unroll
            for (int ks = 0; ks < 2; ++ks) { const u32x4 t = (u32x4){wpk[2 * ks][0], wpk[2 * ks][1], wpk[2 * ks + 1][0], wpk[2 * ks + 1][1]}; bw[ks] = __builtin_bit_cast(bf16x8, t); }
            const float e = scal[64 + l];
#pragma unroll
            for (int k2 = 0; k2 < 2; ++k2) { const int pt = 2 * pr + k2;
                f32x4 dg = (f32x4){0.f, 0.f, 0.f, 0.f}, of = dg;
#pragma unroll
                for (int ks = 0; ks < 2; ++ks) { const LAS bf16* xp = xT + (16 * pt + fr) * 72 + ks * 32 + 4 * fq; const u32x2 lo = *(const LAS u32x2*)xp, hi = *(const LAS u32x2*)(xp + 16);
                    const u32x4 t = (u32x4){lo.x, lo.y, hi.x, hi.y}; dg = mfma16(__builtin_bit_cast(bf16x8, t), bw[ks], dg); }
#pragma unroll
                for (int ks = 0; ks < 4; ++ks) { const bf16x8 af = *(const LAS bf16x8*)(HA + (16 * pt + fr) * 136 + ks * 32 + fq * 8); of = mfma16(af, cf[ks], of); }
                const float zf[4] = {bflo(zr[k2].x), bfhi(zr[k2].x), bflo(zr[k2].y), bfhi(zr[k2].y)}; float y[4];
#pragma unroll
                for (int i = 0; i < 4; ++i) { const float xv = bf1(xT[(16 * pt + 4 * fq + i) * 72 + l]); y[i] = (dg[i] + of[i] * e + d_h * xv) * silu(zf[i]); }
                if (l < nvalid) { u32x2 wv; wv.x = pk2(y[0], y[1]); wv.y = pk2(y[2], y[3]); *(u32x2*)(Z + (size_t)(rbase + l) * ZW + h * 64 + 16 * pt + 4 * fq) = wv; } }
        }
        __syncthreads();
    }
#undef SSD_PREFETCH
#undef SSD_DTLOAD
#undef SSD_SCAN
}
__device__ __forceinline__ void ssd_pass_a(const Args& a, LAS unsigned char* lds, int G, int bid) {
    const int tid = threadIdx.x;
    float* SEG = (float*)(a.ws + WS_SEG); float* SEGD = (float*)(a.ws + WS_SEGD);
    for (int u = bid; u < 192; u += G) { const int bh = u / 3, seg = u - bh * 3, b = bh >> 5, h = bh & 31;
        f32x4 st[2][2];
#pragma unroll
        for (int i = 0; i < 2; ++i) { st[i][0] = (f32x4){0.f, 0.f, 0.f, 0.f}; st[i][1] = st[i][0]; }
        float logdec = 0.f; const float a_h = -__expf(a.in[I_ALOG][h]);
        ssd_stream<false>(a, lds, st, b * SEQ + seg * 2048, 32, 64, h, a_h, 0.f, logdec);
        f32x4* sp = (f32x4*)(SEG + (size_t)u * 8192);
#pragma unroll
        for (int i = 0; i < 2; ++i)
#pragma unroll
            for (int j = 0; j < 2; ++j) sp[(i * 2 + j) * NTHR + tid] = st[i][j];
        if (tid == 0) SEGD[u] = logdec;
    }
}
__device__ __forceinline__ void ssd_pass_b(const Args& a, LAS unsigned char* lds, int G, int bid) {
    const int tid = threadIdx.x, lane = tid & 63, w = tid >> 6, fr = lane & 15, fq = lane >> 4, nq4 = w & 3, pr = w >> 2;
    const float* SEG = (const float*)(a.ws + WS_SEG); const float* SEGD = (const float*)(a.ws + WS_SEGD);
    for (int u = bid; u < 512; u += G) {
        f32x4 st[2][2]; float logdec = 0.f;
        if (u < 256) { const int bh = u >> 2, seg = u & 3, b = bh >> 5, h = bh & 31;
#pragma unroll
            for (int i = 0; i < 2; ++i) { st[i][0] = (f32x4){0.f, 0.f, 0.f, 0.f}; st[i][1] = st[i][0]; }
            for (int s = 0; s < seg; ++s) { const float dec = __expf(SEGD[bh * 3 + s]); const f32x4* sp = (const f32x4*)(SEG + (size_t)(bh * 3 + s) * 8192);
#pragma unroll
                for (int i = 0; i < 2; ++i)
#pragma unroll
                    for (int j = 0; j < 2; ++j) st[i][j] = st[i][j] * dec + sp[(i * 2 + j) * NTHR + tid]; }
            const float a_h = -__expf(a.in[I_ALOG][h]), d_h = a.in[I_SSMD][h];
            ssd_stream<true>(a, lds, st, b * SEQ + seg * 2048, 32, 64, h, a_h, d_h, logdec);
            if (seg == 3) { float* op = a.out + O_SSP + (size_t)bh * 8192;
#pragma unroll
                for (int nt = 0; nt < 2; ++nt)
#pragma unroll
                    for (int pt = 0; pt < 2; ++pt) *(f32x4*)(op + (32 * pr + 16 * pt + fr) * 128 + 32 * nq4 + 16 * nt + 4 * fq) = st[nt][pt]; }
        } else { const int v = u - 256, bs = v >> 5, h = v & 31;
            const float* ip = a.in[I_SSM] + (size_t)v * 8192;
#pragma unroll
            for (int nt = 0; nt < 2; ++nt)
#pragma unroll
                for (int pt = 0; pt < 2; ++pt) st[nt][pt] = *(const f32x4*)(ip + (32 * pr + 16 * pt + fr) * 128 + 32 * nq4 + 16 * nt + 4 * fq);
            const float a_h = -__expf(a.in[I_ALOG][h]), d_h = a.in[I_SSMD][h];
            ssd_stream<true>(a, lds, st, MPR + bs * 16, 1, 16, h, a_h, d_h, logdec);
            float* op = a.out + O_SSS + (size_t)v * 8192;
#pragma unroll
            for (int nt = 0; nt < 2; ++nt)
#pragma unroll
                for (int pt = 0; pt < 2; ++pt) *(f32x4*)(op + (32 * pr + 16 * pt + fr) * 128 + 32 * nq4 + 16 * nt + 4 * fq) = st[nt][pt];
        }
    }
}
__device__ __forceinline__ void gnorm_phase(const Args& a, int G, int bid) {
    const int tid = threadIdx.x, lane = tid & 63, wave = tid >> 6, gw = bid * NWAVES + wave, NGW = G * NWAVES;
    bf16* Z = (bf16*)(a.ws + WS_Z); const float* ng = a.in[I_SSMNG];
    for (int it = gw; it < MV * 4; it += NGW) { const int row = it >> 2, g = it & 3;
        u32x4* p = (u32x4*)(Z + (size_t)row * ZW + g * 512 + lane * 8); float f[8]; unpack8(*p, f);
        float ss = 0.f;
#pragma unroll
        for (int j = 0; j < 8; ++j) ss += f[j] * f[j];
        const float r = __builtin_amdgcn_rsqf(wave_sum(ss) * (1.f / 512.f) + EPS);
        const f32x4 g0 = *(const f32x4*)(ng + g * 512 + lane * 8), g1 = *(const f32x4*)(ng + g * 512 + lane * 8 + 4);
        f[0] *= r * g0.x; f[1] *= r * g0.y; f[2] *= r * g0.z; f[3] *= r * g0.w; f[4] *= r * g1.x; f[5] *= r * g1.y; f[6] *= r * g1.z; f[7] *= r * g1.w;
        *p = pack8(f); }
}

#define XB_TMO      128
#define XB_XCNT(j)  (256  + 64 * (j))
#define XB_XSUB(j)  (1280 + 64 * (j))
#define XB_XGEN(j)  (2304 + 64 * (j))
#define XB_TOP      3328
#define XB_TOPGEN   3392
#define XCD_BAR_WORDS 3456
#define XB_SPIN_CAP (1u << 18)

__device__ __forceinline__ unsigned xb_ld(unsigned* p)              { return __hip_atomic_load(p, __ATOMIC_RELAXED, __HIP_MEMORY_SCOPE_AGENT); }
__device__ __forceinline__ unsigned xb_add(unsigned* p, unsigned v) { return __hip_atomic_fetch_add(p, v, __ATOMIC_RELAXED, __HIP_MEMORY_SCOPE_AGENT); }
__device__ __forceinline__ unsigned xb_xcc_id() { return (unsigned)__builtin_amdgcn_s_getreg((3 << 11) | 20) & 0xFu; }
#define XB_SPIN(cond, bar) do { unsigned _sp = 0; while (cond) { __builtin_amdgcn_s_sleep(1); \
    if ((++_sp & 255u) == 0u) { if (xb_ld(&(bar)[XB_TMO])) break; if (_sp > XB_SPIN_CAP) { atomicAdd(&(bar)[XB_TMO], 1u); break; } } } } while (0)

struct XcdBarrier {
    unsigned* bar; unsigned x;
    volatile LAS unsigned* st;
};

__device__ __forceinline__ XcdBarrier xcd_barrier_post(unsigned* bar, volatile LAS unsigned* st) {
    XcdBarrier b; b.bar = bar; b.x = xb_xcc_id(); b.st = st;
    if (threadIdx.x == 0) (void)xb_add(&bar[XB_XCNT(b.x)], 1u);
    return b;
}
__device__ __forceinline__ void xcd_barrier_complete(unsigned* bar, unsigned x, unsigned& nloc, unsigned& nx) {
    const unsigned G = gridDim.x * gridDim.y * gridDim.z;
    unsigned sum, cnt, mine, sp = 0u;
    for (;;) {
        sum = 0u; cnt = 0u; mine = 0u;
#pragma unroll
        for (unsigned j = 0; j < 16; ++j) { const unsigned c = xb_ld(&bar[XB_XCNT(j)]); sum += c; cnt += (c > 0u) ? 1u : 0u; mine = (j == x) ? c : mine; }
        if (sum == G) break;
        __builtin_amdgcn_s_sleep(1);
        if ((++sp & 255u) == 0u) { if (xb_ld(&bar[XB_TMO])) break; if (sp > XB_SPIN_CAP) { atomicAdd(&bar[XB_TMO], 1u); break; } }
    }
    nloc = mine > 0u ? mine : 1u; nx = cnt > 0u ? cnt : 1u;
}

__device__ __forceinline__ void xcd_barrier(const XcdBarrier& b) {
    asm volatile("s_waitcnt vmcnt(0)" ::: "memory");
    __syncthreads();
    if (threadIdx.x == 0) {
        unsigned* bar = b.bar;
        __builtin_amdgcn_s_waitcnt(0);
        unsigned nloc = b.st[0], nx = b.st[1];
        if (nloc == 0u) { xcd_barrier_complete(bar, b.x, nloc, nx); b.st[0] = nloc; b.st[1] = nx; }
        const unsigned old = xb_add(&bar[XB_XSUB(b.x)], 1u);
        const unsigned gen = old / nloc;
        if (old + 1u == (gen + 1u) * nloc) {
            __builtin_amdgcn_fence(__ATOMIC_RELEASE, "agent");
            asm volatile("s_waitcnt vmcnt(0)" ::: "memory");
            const unsigned og = xb_add(&bar[XB_TOP], 1u);
            const unsigned tg = og / nx;
            if (og + 1u == (tg + 1u) * nx) xb_add(&bar[XB_TOPGEN], 1u);
            else XB_SPIN(xb_ld(&bar[XB_TOPGEN]) == tg, bar);
            __builtin_amdgcn_fence(__ATOMIC_ACQUIRE, "agent");
            xb_add(&bar[XB_XGEN(b.x)], 1u);
            asm volatile("s_waitcnt vmcnt(0)" ::: "memory");
        } else {
            XB_SPIN(xb_ld(&bar[XB_XGEN(b.x)]) == gen, bar);
            __builtin_amdgcn_fence(__ATOMIC_ACQUIRE, "agent");
            asm volatile("s_waitcnt vmcnt(0)" ::: "memory");
        }
    }
    __syncthreads();
}

#ifndef MK_ONE_LAUNCH
#define MK_ONE_LAUNCH 1
#endif
constexpr int N_PHASES = 18;
__global__ void __launch_bounds__(NTHR, 2) mega_fwd(Args args) {
    extern __shared__ __attribute__((aligned(16))) unsigned char lds_raw[];
    LAS unsigned char* lds = (LAS unsigned char*)lds_raw;
    cg::grid_group grid = cg::this_grid();
    volatile LAS unsigned* MISC = (volatile LAS unsigned*)(lds + 131072 + 320);
    if (threadIdx.x < 32) MISC[threadIdx.x] = 0u;
    __syncthreads();
    XcdBarrier bar = xcd_barrier_post((unsigned*)(args.ws + WS_BAR), MISC + 8);
    if (args.ph_lo > args.ph_hi) grid.sync();
    const int G = gridDim.x, bid = blockIdx.x;
    unsigned char* ws = args.ws;
    const int lo = args.ph_lo, hi = args.ph_hi;
    const float* NG = args.in[I_NG];
    bf16* XN = (bf16*)(ws + WS_XN); bf16* MIX = (bf16*)(ws + WS_MIX); bf16* HB = (bf16*)(ws + WS_H);
#ifndef PROBE_DBL
#define PROBE_DBL 0
#endif
#define IN(k) (lo <= (k) && (k) < hi)
#define PH(k, ...) if (IN(k)) { __VA_ARGS__ if ((PROBE_DBL >> (k)) & 1) { __VA_ARGS__ } }
#define SEAM(k) do { if (IN(k) && IN((k) + 1)) xcd_barrier(bar); } while (0)
#define GEMM_SPLIT(Aptr, Wptr, NN, KK, E) do { pg8::Gemm g_{(const pg8::bf16_t*)(Aptr), (const pg8::bf16_t*)(Wptr), MPAD, (NN), (KK)}; pg8::StaticOrder S_; S_.init(MPAD, (NN), G, bid); \
        pg8::gemm_phase<pg8::EpiSplit, pg8::StaticOrder, true, true>(lds, g_, S_, E); } while (0)
#define GEMM_SWIGLU(Aptr, Wptr, E) do { pg8::Gemm g_{(const pg8::bf16_t*)(Aptr), (const pg8::bf16_t*)(Wptr), MPAD, 2 * DFF, DM}; pg8::StaticOrder S_; S_.init(MPAD, 2 * DFF, G, bid); \
        pg8::gemm_phase<pg8::EpiSwiGLU, pg8::StaticOrder, true, true>(lds, g_, S_, E); } while (0)
    PH(0, p0_prologue(args, lds, G, bid);) SEAM(0);
    PH(1, pg8::EpiSplit E{(bf16*)(ws + WS_P0), AB_IN, AB_IN, nullptr, 0, AB_IN, nullptr, 0, nullptr}; GEMM_SPLIT(XN, ws + WS_W_ABIN, AB_IN, DM, E);) SEAM(1);
    PH(2, attn_phase(args, lds, G, bid);) SEAM(2);
    PH(3, pg8::EpiSplit E{MIX, DM, DM, nullptr, 0, DM, nullptr, 0, nullptr}; GEMM_SPLIT(ws + WS_CAT, ws + WS_W_ABOUT, DM, DM, E);) SEAM(3);
    PH(4, nrn_rows<true>(args, NG + 1 * DM, NG + 2 * DM, G, bid);) SEAM(4);
    PH(5, pg8::EpiSwiGLU E{HB, DFF}; GEMM_SWIGLU(XN, ws + WS_W_UP0, E);) SEAM(5);
    PH(6, pg8::EpiSplit E{MIX, DM, DM, nullptr, 0, DM, nullptr, 0, nullptr}; GEMM_SPLIT(HB, ws + WS_W_DN0, DM, DFF, E);) SEAM(6);
    PH(7, nrn_rows<true>(args, NG + 3 * DM, NG + 4 * DM, G, bid);) SEAM(7);
    PH(8, pg8::EpiSplit E{(bf16*)(ws + WS_Z), ZW, ZW, (bf16*)(ws + WS_XBC), XBCW, ZW + XBCW, (float*)(ws + WS_DT), 32, (bf16*)(ws + WS_HALO)}; GEMM_SPLIT(XN, ws + WS_W_SSMIN, SSM_INP, DM, E);) SEAM(8);
    PH(9, ssmconv_phase(args, G, bid);) SEAM(9);
    PH(10, ssd_pass_a(args, lds, G, bid);) SEAM(10);
    PH(11, ssd_pass_b(args, lds, G, bid);) SEAM(11);
    PH(12, gnorm_phase(args, G, bid);) SEAM(12);
    PH(13, pg8::EpiSplit E{MIX, DM, DM, nullptr, 0, DM, nullptr, 0, nullptr}; GEMM_SPLIT(ws + WS_Z, ws + WS_W_SSMOUT, DM, ZW, E);) SEAM(13);
    PH(14, nrn_rows<true>(args, NG + 5 * DM, NG + 6 * DM, G, bid);) SEAM(14);
    PH(15, pg8::EpiSwiGLU E{HB, DFF}; GEMM_SWIGLU(XN, ws + WS_W_UP1, E);) SEAM(15);
    PH(16, pg8::EpiSplit E{MIX, DM, DM, nullptr, 0, DM, nullptr, 0, nullptr}; GEMM_SPLIT(HB, ws + WS_W_DN1, DM, DFF, E);) SEAM(16);
    PH(17, nrn_rows<false>(args, NG + 7 * DM, NG + 7 * DM, G, bid);)
#undef IN
#undef SEAM
}

extern "C" void kernel_launch(void* const* d_in, const int* in_sizes, int n_in, void* d_out, int out_size, void* d_ws, size_t ws_size, hipStream_t stream) {
    static int grid = 0;
    if (grid == 0) {
        if (n_in != 23 || out_size != (int)O_END || ws_size < WS_END) { fprintf(stderr, "kernel_launch: unexpected shapes (n_in %d out %d ws %zu)\n", n_in, out_size, ws_size); grid = -1; return; }
        int dev = 0, cus = 0, per_cu = 0;
        (void)hipGetDevice(&dev); (void)hipDeviceGetAttribute(&cus, hipDeviceAttributeMultiprocessorCount, dev);
        if (hipFuncSetAttribute((const void*)mega_fwd, hipFuncAttributeMaxDynamicSharedMemorySize, LDS_BYTES) != hipSuccess) { fprintf(stderr, "kernel_launch: hipFuncSetAttribute failed\n"); grid = -1; return; }
        if (hipOccupancyMaxActiveBlocksPerMultiprocessor(&per_cu, (const void*)mega_fwd, NTHR, LDS_BYTES) != hipSuccess || per_cu < 1) { fprintf(stderr, "kernel_launch: occupancy query gave %d\n", per_cu); per_cu = 1; }
        (void)hipGetLastError();
        grid = cus * 1;
        if (grid <= 0) grid = 256;
    }
    if (grid < 0) return;
    Args a{};
    for (int i = 0; i < 23; ++i) a.in[i] = (const float*)d_in[i];
    a.out = (float*)d_out; a.ws = (unsigned char*)d_ws;
    if (hipMemsetAsync((char*)d_ws + WS_BAR, 0, BAR_BYTES, stream) != hipSuccess) { fprintf(stderr, "kernel_launch: memset failed\n"); return; }
#if MK_ONE_LAUNCH
    a.ph_lo = 0; a.ph_hi = N_PHASES;
    void* kargs[] = {&a};
    hipError_t e = hipLaunchCooperativeKernel((const void*)mega_fwd, dim3(grid), dim3(NTHR), kargs, LDS_BYTES, stream);
    if (e != hipSuccess) fprintf(stderr, "kernel_launch: cooperative launch failed: %s (grid %d)\n", hipGetErrorString(e), grid);
#else
    for (int p = 0; p < N_PHASES; ++p) { a.ph_lo = p; a.ph_hi = p + 1; hipLaunchKernelGGL(mega_fwd, dim3(grid), dim3(NTHR), LDS_BYTES, stream, a); }
#endif
}
```

```cpp
#include <hip/hip_runtime.h>
#include <hip/hip_cooperative_groups.h>
#include <cstdio>
#include <cstdint>
namespace cg = cooperative_groups;
#define MK_ONE_LAUNCH 1
namespace pg8 {
#define PG8_LAS __attribute__((address_space(3)))
typedef unsigned short bf16_t;
typedef short bf16x8 __attribute__((ext_vector_type(8)));
typedef float f32x4 __attribute__((ext_vector_type(4)));
typedef unsigned u32x4 __attribute__((ext_vector_type(4)));
constexpr int BM = 256, BK = 64, HALF = 128, HTB = HALF * BK * 2  , STAGE_BYTES = 8 * HTB, NXCD = 8, WGM = 8;

__host__ __device__ __forceinline__ int lds_byte(int r, int c) { const int st = (r >> 4) * 2 + (c >> 5), rr = r & 15, cc = c & 31, ob = rr * 64 + cc * 2; return st * 1024 + (ob ^ (((ob >> 9) & 1) << 5)); }
__host__ __device__ __forceinline__ void stage_rc(int b, int& R, int& C) { const int st = b / 1024, sb = b % 1024, swz = sb ^ (((sb >> 9) & 1) << 5); R = (st >> 1) * 16 + swz / 64; C = (st & 1) * 32 + (swz % 64) / 2; }
__host__ __device__ __forceinline__ int perm32(int rho) { const int n = rho >> 4, i = rho & 15; return 8 * (i >> 2) + 4 * n + (i & 3); }

struct Unit { int pm, pn; };
struct Gemm { const bf16_t* A; const bf16_t* Bt; int M, N, K; };

struct StaticOrder {
    int nM, nN, nwg, G, c;
    __host__ __device__ void init(int M, int N, int G_, int c_) { nM = M / BM; nN = N / BM; nwg = nM * nN; G = G_; c = c_; }
    __host__ __device__ bool next(int i, Unit& u) const {
        const long L = (long)i * G + c; if (L >= nwg) return false;
        int wgid = (int)L; { const int q = nwg / NXCD, r = nwg % NXCD, xcd = wgid % NXCD, off = wgid / NXCD; wgid = (xcd < r ? xcd * (q + 1) : r * (q + 1) + (xcd - r) * q) + off; }
        const int nig = WGM * nN, gid = wgid / nig, fm = gid * WGM, gsz = (nM - fm) < WGM ? (nM - fm) : WGM;
        u.pm = fm + ((wgid % nig) % gsz); u.pn = (wgid % nig) / gsz; return true;
    }
    __device__ __forceinline__ void a_ready(const Unit&) const {}
    __device__ __forceinline__ void done(const Unit&) const {}
};

__device__ __forceinline__ unsigned cvt_pk_bf16(float lo, float hi) { unsigned r; asm volatile("v_cvt_pk_bf16_f32 %0, %1, %2" : "=v"(r) : "v"(lo), "v"(hi)); return r; }
__device__ __forceinline__ float silu_f(float v) { return v * __builtin_amdgcn_rcpf(1.0f + __expf(-v)); }
struct EpiSplit {
    static constexpr bool PERM = true, AFTER_DRAIN = false;
    bf16_t* O0; int ld0; int c1; bf16_t* O1; int ld1; int c2; float* O2; int ld2; bf16_t* halo;
    __device__ __forceinline__ void operator()(const f32x4 (&acc)[2][2][4][2], const Unit& u, int wr, int wc, int fr, int fq) const {
        const int row0 = u.pm * BM + wr * 64 + fr; const int colt = u.pn * BM;
        if (colt >= c2) {
            if (wc == 0) {
#pragma unroll
                for (int ai = 0; ai < 2; ++ai)
#pragma unroll
                    for (int m = 0; m < 4; ++m) { float* rp = O2 + (size_t)(row0 + ai * HALF + m * 16) * ld2 + 8 * fq; *(f32x4*)rp = acc[ai][0][m][0]; *(f32x4*)(rp + 4) = acc[ai][0][m][1]; }
            }
            return;
        }
        bf16_t* base; int ld, cb; bool hal = false;
        if (colt < c1) { base = O0; ld = ld0; cb = colt; } else { base = O1; ld = ld1; cb = colt - c1; hal = (halo != nullptr); }
        const int col0 = cb + wc * 32 + 8 * fq;
#pragma unroll
        for (int ai = 0; ai < 2; ++ai)
#pragma unroll
            for (int m = 0; m < 4; ++m) { const int r = row0 + ai * HALF + m * 16; bf16_t* rowp = base + (size_t)r * ld + col0;
#pragma unroll
                for (int bj = 0; bj < 2; ++bj) { const f32x4 v0 = acc[ai][bj][m][0], v1 = acc[ai][bj][m][1];
                    u32x4 w; w.x = cvt_pk_bf16(v0[0], v0[1]); w.y = cvt_pk_bf16(v0[2], v0[3]); w.z = cvt_pk_bf16(v1[0], v1[1]); w.w = cvt_pk_bf16(v1[2], v1[3]);
                    *(u32x4*)(rowp + bj * HALF) = w;
                    if (m == 3 && hal && fr >= 13) *(u32x4*)(halo + (size_t)((r >> 6) * 3 + (fr - 13)) * ld1 + col0 + bj * HALF) = w; } }
    }
};
struct EpiSwiGLU {
    static constexpr bool PERM = false, AFTER_DRAIN = false;
    bf16_t* H; int ldh;
    __device__ __forceinline__ void operator()(const f32x4 (&acc)[2][2][4][2], const Unit& u, int wr, int wc, int fr, int fq) const {
        const int row0 = u.pm * BM + wr * 64 + fr; const int hcol0 = (u.pn * BM + wc * 32) / 2 + 4 * fq;
        typedef unsigned u32x2v __attribute__((ext_vector_type(2)));
#pragma unroll
        for (int ai = 0; ai < 2; ++ai)
#pragma unroll
            for (int m = 0; m < 4; ++m) { bf16_t* rowp = H + (size_t)(row0 + ai * HALF + m * 16) * ldh + hcol0;
#pragma unroll
                for (int bj = 0; bj < 2; ++bj) { const f32x4 g = acc[ai][bj][m][0], up = acc[ai][bj][m][1];
                    u32x2v w; w.x = cvt_pk_bf16(silu_f(g[0]) * up[0], silu_f(g[1]) * up[1]); w.y = cvt_pk_bf16(silu_f(g[2]) * up[2], silu_f(g[3]) * up[3]);
                    *(u32x2v*)(rowp + bj * 64) = w; } }
    }
};
template <class Epi, class Sched, bool ALIGN_EPI = false, bool SP2 = false>
__device__ __forceinline__ void gemm_phase(PG8_LAS unsigned char* lds, const Gemm g, const Sched& S, const Epi& E) {
    const int tid = threadIdx.x, wid = __builtin_amdgcn_readfirstlane(tid >> 6), lane = tid & 63, wr = wid >> 2, wc = wid & 3, fr = lane & 15, fq = lane >> 4;
    const int K = g.K, nt = K / BK;
    unsigned voffA[2], voffB[2];
#pragma unroll
    for (int i = 0; i < 2; ++i) { int R, C; stage_rc(tid * 16 + i * 8192, R, C); const int Rb = Epi::PERM ? ((R & ~31) + perm32(R & 31)) : R;
        voffA[i] = (unsigned)(R * K + C) * 2u; voffB[i] = (unsigned)(Rb * K + C) * 2u; }
    const size_t kstep = (size_t)(BK * 2);
    const size_t hstep = (size_t)HALF * K * 2;
    const size_t tstep = 2 * hstep;
    const unsigned ldsw = (unsigned)wid * 1024u;
    const int aoff = lds_byte(wr * 64 + fr, fq * 8), boff = lds_byte(wc * 32 + fr, fq * 8);
#define PG8_SA(b, h) (((b) * 2 + (h)) * HTB)
#define PG8_SB(b, h) ((4 + (b) * 2 + (h)) * HTB)
#define PG8_STAGE(bufoff, gbase, voff) do { _Pragma("unroll") for (int _i = 0; _i < 2; ++_i) \
        __builtin_amdgcn_global_load_lds((const unsigned*)((const char*)(gbase) + (voff)[_i]), (PG8_LAS unsigned*)(lds + (bufoff) + ldsw + _i * 8192), 16, 0, 0); } while (0)
#define PG8_LDA(dst, b, h) do { _Pragma("unroll") for (int m = 0; m < 4; ++m) _Pragma("unroll") for (int k = 0; k < 2; ++k) dst[m][k] = *(const PG8_LAS bf16x8*)(lds + PG8_SA(b, h) + aoff + m * 2048 + k * 1024); } while (0)
#define PG8_LDB(dst, b, h) do { _Pragma("unroll") for (int n = 0; n < 2; ++n) _Pragma("unroll") for (int k = 0; k < 2; ++k) dst[n][k] = *(const PG8_LAS bf16x8*)(lds + PG8_SB(b, h) + boff + n * 2048 + k * 1024); } while (0)
#define PG8_MMA(ai, bj, At, Bt) do { __builtin_amdgcn_s_setprio(1); _Pragma("unroll") for (int m = 0; m < 4; ++m) _Pragma("unroll") for (int n = 0; n < 2; ++n) _Pragma("unroll") for (int k = 0; k < 2; ++k) \
        acc[ai][bj][m][n] = __builtin_amdgcn_mfma_f32_16x16x32_bf16(Bt[n][k], At[m][k], acc[ai][bj][m][n], 0, 0, 0); __builtin_amdgcn_s_setprio(0); } while (0)
#define PG8_WAIT_V(n) asm volatile("s_waitcnt vmcnt(" #n ")" ::: "memory")
#define PG8_WAIT_L(n) asm volatile("s_waitcnt lgkmcnt(" #n ")" ::: "memory")
#define PG8_BAR __builtin_amdgcn_s_barrier()
#define PG8_SCHED __builtin_amdgcn_sched_barrier(0)
    Unit cur, nxt; int ui = 0;
    if (!S.next(0, cur)) return;
    f32x4 acc[2][2][4][2];
#pragma unroll
    for (int a = 0; a < 2; ++a)
#pragma unroll
        for (int b = 0; b < 2; ++b)
#pragma unroll
            for (int m = 0; m < 4; ++m)
#pragma unroll
                for (int n = 0; n < 2; ++n) acc[a][b][m][n] = (f32x4){0.f, 0.f, 0.f, 0.f};
    bf16x8 At[4][2], B0[2][2], B1[2][2];
    const char* cA = (const char*)g.A + (size_t)cur.pm * tstep; const char* cB = (const char*)g.Bt + (size_t)cur.pn * tstep;
    S.a_ready(cur);
    if constexpr (SP2) {
        PG8_STAGE(PG8_SB(0, 0), cB, voffB); PG8_STAGE(PG8_SB(0, 1), cB + hstep, voffB); PG8_STAGE(PG8_SA(0, 0), cA, voffA); PG8_STAGE(PG8_SA(0, 1), cA + hstep, voffA);
        if (wr == 1) PG8_BAR;
        PG8_WAIT_V(2); PG8_BAR;
        PG8_STAGE(PG8_SB(1, 0), cB + kstep, voffB); PG8_STAGE(PG8_SA(1, 0), cA + kstep, voffA); PG8_STAGE(PG8_SB(1, 1), cB + hstep + kstep, voffB);
        PG8_WAIT_V(6); PG8_BAR;
    } else {
        PG8_STAGE(PG8_SB(0, 0), cB, voffB); PG8_STAGE(PG8_SA(0, 0), cA, voffA); PG8_STAGE(PG8_SB(0, 1), cB + hstep, voffB); PG8_STAGE(PG8_SA(0, 1), cA + hstep, voffA);
        if (wr == 1) PG8_BAR;
        PG8_WAIT_V(4); PG8_BAR;
        PG8_STAGE(PG8_SB(1, 0), cB + kstep, voffB); PG8_STAGE(PG8_SA(1, 0), cA + kstep, voffA); PG8_STAGE(PG8_SB(1, 1), cB + hstep + kstep, voffB);
        PG8_WAIT_V(6); PG8_BAR;
    }
    for (;;) {
        const bool has_next = S.next(ui + 1, nxt);
        const char* nA = has_next ? (const char*)g.A + (size_t)nxt.pm * tstep : cA; const char* nB = has_next ? (const char*)g.Bt + (size_t)nxt.pn * tstep : cB;
        for (int t = 0; t < nt; t += 2) {
            const bool last = (t == nt - 2);
            const char* a1 = cA + (size_t)(t + 1) * kstep;
            const char* a2 = last ? nA : cA + (size_t)(t + 2) * kstep; const char* b2 = last ? nB : cB + (size_t)(t + 2) * kstep;
            const char* a3 = a2 + kstep; const char* b3 = b2 + kstep;
            if (last && has_next) S.a_ready(nxt);
            if constexpr (SP2) {
            PG8_LDB(B0, 0, 0); PG8_LDB(B1, 0, 1); PG8_SCHED; PG8_LDA(At, 0, 0); PG8_STAGE(PG8_SA(1, 1), a1 + hstep, voffA);
            PG8_WAIT_V(8); PG8_WAIT_L(0); PG8_BAR; PG8_MMA(0, 0, At, B0); PG8_MMA(0, 1, At, B1); PG8_BAR; PG8_SCHED;
            PG8_LDA(At, 0, 1); PG8_STAGE(PG8_SB(0, 0), b2, voffB); PG8_STAGE(PG8_SB(0, 1), b2 + hstep, voffB); PG8_STAGE(PG8_SA(0, 0), a2, voffA);
            PG8_WAIT_V(8); PG8_WAIT_L(0); PG8_BAR; PG8_MMA(1, 0, At, B0); PG8_MMA(1, 1, At, B1); PG8_BAR; PG8_SCHED;
            PG8_LDB(B0, 1, 0); PG8_LDB(B1, 1, 1); PG8_SCHED; PG8_LDA(At, 1, 0); PG8_STAGE(PG8_SA(0, 1), a2 + hstep, voffA);
            PG8_WAIT_V(8); PG8_WAIT_L(0); PG8_BAR; PG8_MMA(0, 0, At, B0); PG8_MMA(0, 1, At, B1); PG8_BAR; PG8_SCHED;
            PG8_LDA(At, 1, 1); PG8_STAGE(PG8_SB(1, 0), b3, voffB); PG8_STAGE(PG8_SB(1, 1), b3 + hstep, voffB); PG8_STAGE(PG8_SA(1, 0), a3, voffA);
            PG8_WAIT_V(8); PG8_WAIT_L(0); PG8_BAR; PG8_MMA(1, 0, At, B0); PG8_MMA(1, 1, At, B1); PG8_BAR; PG8_SCHED;
            } else {
            PG8_LDB(B0, 0, 0); PG8_SCHED; PG8_LDA(At, 0, 0); PG8_STAGE(PG8_SA(1, 1), a1 + hstep, voffA);
            PG8_WAIT_L(8); PG8_BAR; PG8_WAIT_L(0); PG8_MMA(0, 0, At, B0); PG8_BAR; PG8_SCHED;
            PG8_LDB(B1, 0, 1); PG8_STAGE(PG8_SB(0, 0), b2, voffB);
            PG8_BAR; PG8_WAIT_L(0); PG8_MMA(0, 1, At, B1); PG8_BAR;
            PG8_LDA(At, 0, 1); PG8_STAGE(PG8_SA(0, 0), a2, voffA);
            PG8_BAR; PG8_WAIT_L(0); PG8_MMA(1, 0, At, B0); PG8_BAR; PG8_SCHED;
            PG8_STAGE(PG8_SB(0, 1), b2 + hstep, voffB);
            PG8_WAIT_V(6); PG8_BAR; PG8_MMA(1, 1, At, B1); PG8_BAR;
            PG8_LDB(B0, 1, 0); PG8_SCHED; PG8_LDA(At, 1, 0); PG8_STAGE(PG8_SA(0, 1), a2 + hstep, voffA);
            PG8_WAIT_L(8); PG8_BAR; PG8_WAIT_L(0); PG8_MMA(0, 0, At, B0); PG8_BAR; PG8_SCHED;
            PG8_LDB(B1, 1, 1); PG8_STAGE(PG8_SB(1, 0), b3, voffB);
            PG8_BAR; PG8_WAIT_L(0); PG8_MMA(0, 1, At, B1); PG8_BAR;
            PG8_LDA(At, 1, 1); PG8_STAGE(PG8_SA(1, 0), a3, voffA);
            PG8_BAR; PG8_WAIT_L(0); PG8_MMA(1, 0, At, B0); PG8_BAR; PG8_SCHED;
            PG8_STAGE(PG8_SB(1, 1), b3 + hstep, voffB);
            PG8_WAIT_V(6); PG8_BAR; PG8_MMA(1, 1, At, B1); PG8_BAR;
            }
        }
        if constexpr (ALIGN_EPI) { if (wr == 0) PG8_BAR; }
        if constexpr (!Epi::AFTER_DRAIN) { E(acc, cur, wr, wc, fr, fq); S.done(cur); }
        if (!has_next) break;
#pragma unroll
        for (int a = 0; a < 2; ++a)
#pragma unroll
            for (int b = 0; b < 2; ++b)
#pragma unroll
                for (int m = 0; m < 4; ++m)
#pragma unroll
                    for (int n = 0; n < 2; ++n) acc[a][b][m][n] = (f32x4){0.f, 0.f, 0.f, 0.f};
        cur = nxt; cA = nA; cB = nB; ++ui;
        if constexpr (ALIGN_EPI) { if (wr == 1) PG8_BAR; }
    }
    PG8_WAIT_V(0);
    if constexpr (!ALIGN_EPI) { if (wr == 0) PG8_BAR; }
    PG8_BAR;
    if constexpr (Epi::AFTER_DRAIN) { E.fused(acc, cur, wr, wc, fr, fq, lds, wid, lane); S.done(cur); }
#undef PG8_SA
#undef PG8_SB
#undef PG8_STAGE
#undef PG8_LDA
#undef PG8_LDB
#undef PG8_MMA
#undef PG8_WAIT_V
#undef PG8_WAIT_L
#undef PG8_BAR
#undef PG8_SCHED
}
}

#define LAS __attribute__((address_space(3)))
typedef unsigned short bf16;
typedef pg8::f32x4 f32x4;
typedef pg8::bf16x8 bf16x8;
typedef pg8::u32x4 u32x4;
typedef unsigned u32x2 __attribute__((ext_vector_type(2)));
typedef float f32x2 __attribute__((ext_vector_type(2)));

constexpr int NWAVES = 8, NTHR = 512;
constexpr int DM = 1024, MPR = 16384, MV = 16512, MPAD = 16640, SEQ = 8192;
constexpr int AB_IN = 2304, DFF = 2816, SSM_INP = 5376, SSM_INV = 5152, XBCW = 3072, ZW = 2048;
constexpr float EPS = 1e-6f;
constexpr size_t MiB = 1u << 20;
constexpr size_t WS_ROPE = 0, WS_BAR = 512 * 1024, BAR_BYTES = 16384;
constexpr size_t WS_W_ABIN = 1 * MiB, WS_W_ABOUT = WS_W_ABIN + 9 * MiB / 2, WS_W_UP0 = WS_W_ABOUT + 2 * MiB, WS_W_DN0 = WS_W_UP0 + 11 * MiB;
constexpr size_t WS_HALO = 1 * MiB, WS_DT = 6 * MiB, WS_SEG = 9 * MiB, WS_SEGD = 16 * MiB;
constexpr size_t WS_W_SSMIN = 24 * MiB, WS_W_SSMOUT = WS_W_SSMIN + 21 * MiB / 2, WS_W_UP1 = WS_W_SSMOUT + 4 * MiB, WS_W_DN1 = WS_W_UP1 + 11 * MiB;
constexpr size_t WS_XN = 55 * MiB;
constexpr size_t WS_P0 = 88 * MiB, WS_CAT = 162 * MiB, WS_MIX = 195 * MiB, WS_H = 88 * MiB, WS_Z = 88 * MiB, WS_XBC = 153 * MiB, WS_END = 256 * MiB;
static_assert(WS_W_DN0 + (size_t)DM * DFF * 2 <= 24 * MiB && WS_W_DN1 + (size_t)DM * DFF * 2 <= WS_XN && WS_XN + (size_t)MPAD * DM * 2 <= WS_P0, "ws map 1");
static_assert(WS_P0 + (size_t)MPAD * AB_IN * 2 <= WS_CAT && WS_CAT + (size_t)MPAD * DM * 2 <= WS_MIX && WS_MIX + (size_t)MPAD * DM * 2 <= WS_END, "ws map 2");
static_assert(WS_H + (size_t)MPAD * DFF * 2 <= WS_MIX && WS_Z + (size_t)MPAD * ZW * 2 <= WS_XBC && WS_XBC + (size_t)MPAD * XBCW * 2 <= WS_END, "ws map 3");
static_assert(WS_HALO + (size_t)260 * 3 * XBCW * 2 <= WS_DT && WS_DT + (size_t)MPAD * 32 * 4 <= WS_SEG && WS_SEG + (size_t)192 * 8192 * 4 <= WS_SEGD, "ws map 4");
constexpr size_t O_Y = 0, O_KP = 16908288, O_VP = O_KP + 32768, O_SCP = O_VP + 32768, O_CCP = O_SCP + 2048, O_SSP = O_CCP + 18432, O_KS = O_SSP + 524288, O_VS = O_KS + 16384,
                 O_SCS = O_VS + 16384, O_CCS = O_SCS + 8192, O_SSS = O_CCS + 73728, O_END = O_SSS + 2097152;
static_assert(O_END == 19730432, "output size");
constexpr int LDS_BYTES = 147456;

struct Args { const float* in[23]; float* out; unsigned char* ws; int ph_lo, ph_hi; };
enum { I_XP = 0, I_XS, I_CK, I_CV, I_SCONV, I_SSMCONV, I_SSM, I_NG, I_ABIN, I_ABOUT, I_SINK, I_SCW, I_SSMIN, I_SSMCW, I_SSMCB, I_DTB, I_ALOG, I_SSMD, I_SSMNG, I_SSMOUT, I_FG, I_FU, I_FD };

#define LDS_WAIT() asm volatile("s_waitcnt lgkmcnt(0)" ::: "memory")
typedef __bf16 bf16x2_t __attribute__((ext_vector_type(2)));
__device__ __forceinline__ unsigned pk2(float lo, float hi) { const f32x2 v = {lo, hi}; const bf16x2_t b = __builtin_convertvector(v, bf16x2_t); return __builtin_bit_cast(unsigned, b); }
__device__ __forceinline__ unsigned short f2bf(float f) { return (unsigned short)(pk2(f, 0.f) & 0xffffu); }
__device__ __forceinline__ float bflo(unsigned w) { return __builtin_bit_cast(float, w << 16); }
__device__ __forceinline__ float bfhi(unsigned w) { return __builtin_bit_cast(float, w & 0xffff0000u); }
__device__ __forceinline__ float bf1(unsigned short h) { return __builtin_bit_cast(float, (unsigned)h << 16); }
__device__ __forceinline__ void unpack8(const u32x4 w, float (&f)[8]) { f[0] = bflo(w.x); f[1] = bfhi(w.x); f[2] = bflo(w.y); f[3] = bfhi(w.y); f[4] = bflo(w.z); f[5] = bfhi(w.z); f[6] = bflo(w.w); f[7] = bfhi(w.w); }
__device__ __forceinline__ u32x4 pack8(const float (&f)[8]) { u32x4 w; w.x = pk2(f[0], f[1]); w.y = pk2(f[2], f[3]); w.z = pk2(f[4], f[5]); w.w = pk2(f[6], f[7]); return w; }
__device__ __forceinline__ float wave_sum(float v) {
#pragma unroll
    for (int o = 1; o < 64; o <<= 1) v += __shfl_xor(v, o);
    return v;
}
__device__ __forceinline__ float silu(float v) { return v * __builtin_amdgcn_rcpf(1.0f + __expf(-v)); }
__device__ __forceinline__ f32x4 mfma16(bf16x8 a, bf16x8 b, f32x4 c) { return __builtin_amdgcn_mfma_f32_16x16x32_bf16(a, b, c, 0, 0, 0); }

__device__ __forceinline__ void transpose_item(const float* W, int K, int N, bf16* WT, int mode, LAS float* scr, int item, int lane) {
    const int nblk = N / 32, kb = item / nblk, nb = item % nblk, k0 = 64 * kb, n0 = 32 * nb;
    float wv_[32];
#pragma unroll
    for (int i = 0; i < 32; ++i) wv_[i] = W[(size_t)(k0 + 2 * i + (lane >> 5)) * N + n0 + (lane & 31)];
#pragma unroll
    for (int i = 0; i < 32; ++i) scr[(2 * i + (lane >> 5)) * 33 + (lane & 31)] = wv_[i];
    LDS_WAIT(); asm volatile("" ::: "memory");
    const int c = lane & 7;
#pragma unroll
    for (int j = 0; j < 4; ++j) { const int n = (lane >> 3) + 8 * j; const LAS float* s = scr + (8 * c) * 33 + n; const int cn = n0 + n;
        const int drow = (mode == 0) ? cn : (((cn >> 4) << 5) + (cn & 15) + (mode == 2 ? 16 : 0));
        u32x4 o; o.x = pk2(s[0 * 33], s[1 * 33]); o.y = pk2(s[2 * 33], s[3 * 33]); o.z = pk2(s[4 * 33], s[5 * 33]); o.w = pk2(s[6 * 33], s[7 * 33]);
        *(u32x4*)(WT + (size_t)drow * K + k0 + 8 * c) = o; }
    LDS_WAIT(); asm volatile("" ::: "memory");
}
__device__ __forceinline__ void p0_prologue(const Args& a, LAS unsigned char* lds, int G, int bid) {
    const int tid = threadIdx.x, lane = tid & 63, wave = tid >> 6;
    unsigned char* ws = a.ws;
    LAS float* scr = (LAS float*)(lds + wave * 16384);
    const int gw = bid * NWAVES + wave, NGW = G * NWAVES;
    constexpr int I_1 = 16 * 72, I_2 = 16 * 32, I_F = 16 * 88, I_D = 44 * 32, I_5 = 16 * 161, I_6 = 32 * 32;
    constexpr int NITEMS = I_1 + I_2 + 4 * I_F + 2 * I_D + I_5 + I_6;
    for (int it = gw; it < NITEMS; it += NGW) {
        int r = it;
        if (r < I_5) { transpose_item(a.in[I_SSMIN], DM, SSM_INV, (bf16*)(ws + WS_W_SSMIN), 0, scr, r, lane); continue; } r -= I_5;
        if (r < I_1) { transpose_item(a.in[I_ABIN], DM, AB_IN, (bf16*)(ws + WS_W_ABIN), 0, scr, r, lane); continue; } r -= I_1;
        if (r < I_2) { transpose_item(a.in[I_ABOUT], DM, DM, (bf16*)(ws + WS_W_ABOUT), 0, scr, r, lane); continue; } r -= I_2;
        if (r < I_F) { transpose_item(a.in[I_FG], DM, DFF, (bf16*)(ws + WS_W_UP0), 1, scr, r, lane); continue; } r -= I_F;
        if (r < I_F) { transpose_item(a.in[I_FU], DM, DFF, (bf16*)(ws + WS_W_UP0), 2, scr, r, lane); continue; } r -= I_F;
        if (r < I_D) { transpose_item(a.in[I_FD], DFF, DM, (bf16*)(ws + WS_W_DN0), 0, scr, r, lane); continue; } r -= I_D;
        if (r < I_6) { transpose_item(a.in[I_SSMOUT], ZW, DM, (bf16*)(ws + WS_W_SSMOUT), 0, scr, r, lane); continue; } r -= I_6;
        if (r < I_F) { transpose_item(a.in[I_FG] + (size_t)DM * DFF, DM, DFF, (bf16*)(ws + WS_W_UP1), 1, scr, r, lane); continue; } r -= I_F;
        if (r < I_F) { transpose_item(a.in[I_FU] + (size_t)DM * DFF, DM, DFF, (bf16*)(ws + WS_W_UP1), 2, scr, r, lane); continue; } r -= I_F;
        transpose_item(a.in[I_FD] + (size_t)DM * DFF, DFF, DM, (bf16*)(ws + WS_W_DN1), 0, scr, r, lane);
    }
    const int gt = bid * NTHR + tid, NGT = G * NTHR;
    { u32x4 z = (u32x4){0u, 0u, 0u, 0u};
      u32x4* p1 = (u32x4*)((bf16*)(ws + WS_W_SSMIN) + (size_t)SSM_INV * DM); for (int i = gt; i < (SSM_INP - SSM_INV) * DM / 8; i += NGT) p1[i] = z;
      u32x4* p2 = (u32x4*)((bf16*)(ws + WS_XN) + (size_t)MV * DM); for (int i = gt; i < (MPAD - MV) * DM / 8; i += NGT) p2[i] = z; }
    { f32x2* rope = (f32x2*)(ws + WS_ROPE);
      for (int i = gt; i < SEQ * 8; i += NGT) { const int pos = i >> 3, k = i & 7;
          const double invf = k == 0 ? 1.0 : k == 1 ? 0.19392274474868576 : k == 2 ? 0.03760603093086393 : k == 3 ? 0.007292664737217109 : k == 4 ? 0.001414213562373095 : k == 5 ? 0.0002742481756762073 : k == 6 ? 5.318295896944988e-05 : 1.031338537721246e-05;
          const double rev = (double)pos * invf * 0.15915494309189535; const float fr = (float)(rev - __builtin_floor(rev));
          rope[i] = (f32x2){__builtin_amdgcn_cosf(fr), __builtin_amdgcn_sinf(fr)}; } }
    const f32x4* g4 = (const f32x4*)(a.in[I_NG]);
    for (int row = gw; row < MV; row += NGW) {
        const f32x4* src = (const f32x4*)(row < MPR ? a.in[I_XP] + (size_t)row * DM : a.in[I_XS] + (size_t)(row - MPR) * DM);
        f32x4 v[4]; float ss = 0.f;
#pragma unroll
        for (int j = 0; j < 4; ++j) { v[j] = src[lane + 64 * j]; ss += (v[j].x * v[j].x + v[j].y * v[j].y) + (v[j].z * v[j].z + v[j].w * v[j].w); }
        const float r = __builtin_amdgcn_rsqf(wave_sum(ss) * (1.f / DM) + EPS);
        u32x2* o = (u32x2*)((bf16*)(ws + WS_XN) + (size_t)row * DM);
#pragma unroll
        for (int j = 0; j < 4; ++j) { const f32x4 g = g4[lane + 64 * j]; u32x2 w; w.x = pk2(v[j].x * r * g.x, v[j].y * r * g.y); w.y = pk2(v[j].z * r * g.z, v[j].w * r * g.w); o[lane + 64 * j] = w; }
    }
}
template <bool SECOND, bool FIRST = false>
__device__ __forceinline__ void nrn_rows(const Args& a, const float* g1, const float* g2, int G, int bid) {
    const int tid = threadIdx.x, lane = tid & 63, wave = tid >> 6;
    const int gw = bid * NWAVES + wave, NGW = G * NWAVES;
    const bf16* mix = (const bf16*)(a.ws + WS_MIX); bf16* xn = (bf16*)(a.ws + WS_XN);
    const f32x4* g14 = (const f32x4*)g1; const f32x4* g24 = (const f32x4*)g2;
    for (int row = gw; row < MV; row += NGW) {
        const u32x2* mp = (const u32x2*)(mix + (size_t)row * DM);
        f32x4* xp = (f32x4*)(a.out + (size_t)row * DM);
        const f32x4* xs = FIRST ? (const f32x4*)(row < MPR ? a.in[I_XP] + (size_t)row * DM : a.in[I_XS] + (size_t)(row - MPR) * DM) : (const f32x4*)xp;
        f32x4 m[4], xv[4]; float ss = 0.f;
#pragma unroll
        for (int j = 0; j < 4; ++j) { const u32x2 w = mp[lane + 64 * j]; m[j] = (f32x4){bflo(w.x), bfhi(w.x), bflo(w.y), bfhi(w.y)}; xv[j] = xs[lane + 64 * j];
            ss += (m[j].x * m[j].x + m[j].y * m[j].y) + (m[j].z * m[j].z + m[j].w * m[j].w); }
        const float r1 = __builtin_amdgcn_rsqf(wave_sum(ss) * (1.f / DM) + EPS);
        float s2 = 0.f;
#pragma unroll
        for (int j = 0; j < 4; ++j) { const f32x4 g = g14[lane + 64 * j]; xv[j] = xv[j] + m[j] * r1 * g; xp[lane + 64 * j] = xv[j];
            s2 += (xv[j].x * xv[j].x + xv[j].y * xv[j].y) + (xv[j].z * xv[j].z + xv[j].w * xv[j].w); }
        if (SECOND) {
            const float r2 = __builtin_amdgcn_rsqf(wave_sum(s2) * (1.f / DM) + EPS);
            u32x2* o = (u32x2*)(xn + (size_t)row * DM);
#pragma unroll
            for (int j = 0; j < 4; ++j) { const f32x4 g = g24[lane + 64 * j]; u32x2 w; w.x = pk2(xv[j].x * r2 * g.x, xv[j].y * r2 * g.y); w.y = pk2(xv[j].z * r2 * g.z, xv[j].w * r2 * g.w); o[lane + 64 * j] = w; }
        }
    }
}

__device__ __forceinline__ void load8_rope(const bf16* hp, int dg, const f32x2* rp, float (&o)[8]) {
    const u32x4 w = *(const u32x4*)(hp + dg * 8); unpack8(w, o);
    if (dg < 2) { float p[8]; const u32x4 w2 = *(const u32x4*)(hp + (1 - dg) * 8); unpack8(w2, p);
#pragma unroll
        for (int j = 0; j < 8; ++j) { const f32x2 cs = rp[j]; o[j] = dg == 0 ? o[j] * cs.x - p[j] * cs.y : o[j] * cs.x + p[j] * cs.y; } }
}
__device__ __forceinline__ void attn_phase(const Args& a, LAS unsigned char* lds, int G, int bid) {
    LAS bf16* Qs = (LAS bf16*)lds;
    LAS bf16* Ks = (LAS bf16*)(lds + 36864);
    LAS bf16* Vt = (LAS bf16*)(lds + 64512);
    const int tid = threadIdx.x, lane = tid & 63, w = tid >> 6, fr = lane & 15, fq = lane >> 4;
    const bf16* P0 = (const bf16*)(a.ws + WS_P0); bf16* CAT = (bf16*)(a.ws + WS_CAT);
    const f32x2* rope = (const f32x2*)(a.ws + WS_ROPE);
    for (int u = bid; u < 528; u += G) {
        const bool smp = u >= 512;
        int b, c = 0, kvh, nq, nkc = 0, nvalid, qrow0;
        if (!smp) { kvh = u & 1; c = (u >> 1) & 127; b = u >> 8; nq = 64; nkc = (c < 2 ? c : 2) + 1; nvalid = 64 * nkc; qrow0 = b * SEQ + c * 64; }
        else { const int v = u - 512; kvh = v & 1; b = v >> 1; nq = 16; nvalid = 144; qrow0 = MPR + b * 16; }
#pragma unroll
        for (int it = 0; it < 4; ++it) { const int item = tid + NTHR * it, q = item >> 3, dg = item & 7, hh = q >> 6, i = q & 63;
            u32x4 o = (u32x4){0u, 0u, 0u, 0u};
            if (i < nq) { const int pos = smp ? 4096 + i : c * 64 + i; float f[8]; load8_rope(P0 + (size_t)(qrow0 + i) * AB_IN + (4 * kvh + hh) * 64, dg, rope + pos * 8, f);
#pragma unroll
                for (int j = 0; j < 8; ++j) f[j] *= 0.125f;
                o = pack8(f); }
            *(LAS u32x4*)(Qs + q * 72 + dg * 8) = o; }
#pragma unroll
        for (int it = 0; it < 3; ++it) { const int kr = lane + 64 * it, dg = w;
            u32x4 ko = (u32x4){0u, 0u, 0u, 0u}, vo = ko;
            if (kr < nvalid) {
                if (smp && kr < 128) { const size_t off = ((size_t)(b * 128 + kr) * 2 + kvh) * 64 + dg * 8;
                    const f32x4 k0 = *(const f32x4*)(a.in[I_CK] + off), k1 = *(const f32x4*)(a.in[I_CK] + off + 4), v0 = *(const f32x4*)(a.in[I_CV] + off), v1 = *(const f32x4*)(a.in[I_CV] + off + 4);
                    ko.x = pk2(k0.x, k0.y); ko.y = pk2(k0.z, k0.w); ko.z = pk2(k1.x, k1.y); ko.w = pk2(k1.z, k1.w); vo.x = pk2(v0.x, v0.y); vo.y = pk2(v0.z, v0.w); vo.z = pk2(v1.x, v1.y); vo.w = pk2(v1.z, v1.w); }
                else { int row, pos; if (smp) { row = MPR + b * 16 + (kr - 128); pos = 4096 + kr - 128; } else { pos = (c - nkc + 1 + (kr >> 6)) * 64 + (kr & 63); row = b * SEQ + pos; }
                    const bf16* rp = P0 + (size_t)row * AB_IN; float f[8]; load8_rope(rp + 512 + kvh * 64, dg, rope + pos * 8, f); ko = pack8(f);
                    vo = *(const u32x4*)(rp + 640 + kvh * 64 + dg * 8); }
            }
            *(LAS u32x4*)(Ks + kr * 72 + dg * 8) = ko;
            LAS bf16* vp = Vt + (dg * 8) * 200 + kr;
            vp[0 * 200] = (bf16)(vo.x & 0xffffu); vp[1 * 200] = (bf16)(vo.x >> 16); vp[2 * 200] = (bf16)(vo.y & 0xffffu); vp[3 * 200] = (bf16)(vo.y >> 16);
            vp[4 * 200] = (bf16)(vo.z & 0xffffu); vp[5 * 200] = (bf16)(vo.z >> 16); vp[6 * 200] = (bf16)(vo.w & 0xffffu); vp[7 * 200] = (bf16)(vo.w >> 16); }
        __syncthreads();
        const int hh = w >> 1, qh = w & 1;
        if (qh * 32 < nq) {
            f32x4 s[12][2];
#pragma unroll
            for (int kt = 0; kt < 12; ++kt) { s[kt][0] = (f32x4){0.f, 0.f, 0.f, 0.f}; s[kt][1] = s[kt][0]; }
#pragma unroll
            for (int ks = 0; ks < 2; ++ks) {
                bf16x8 bq[2];
#pragma unroll
                for (int qt = 0; qt < 2; ++qt) bq[qt] = *(const LAS bf16x8*)(Qs + (w * 32 + qt * 16 + fr) * 72 + ks * 32 + fq * 8);
#pragma unroll
                for (int kt = 0; kt < 12; ++kt) if (kt * 16 < nvalid) { const bf16x8 ak = *(const LAS bf16x8*)(Ks + (kt * 16 + fr) * 72 + ks * 32 + fq * 8);
                    s[kt][0] = mfma16(ak, bq[0], s[kt][0]); s[kt][1] = mfma16(ak, bq[1], s[kt][1]); }
            }
            const float sink = a.in[I_SINK][4 * kvh + hh];
            float inv[2];
#pragma unroll
            for (int qt = 0; qt < 2; ++qt) {
                float m = sink;
#pragma unroll
                for (int kt = 0; kt < 12; ++kt) if (kt * 16 < nvalid) m = fmaxf(fmaxf(m, fmaxf(s[kt][qt][0], s[kt][qt][1])), fmaxf(s[kt][qt][2], s[kt][qt][3]));
                m = fmaxf(m, __shfl_xor(m, 16)); m = fmaxf(m, __shfl_xor(m, 32));
                float sum = 0.f;
#pragma unroll
                for (int kt = 0; kt < 12; ++kt) { if (kt * 16 < nvalid) {
#pragma unroll
                        for (int i = 0; i < 4; ++i) { const float p = __expf(s[kt][qt][i] - m); s[kt][qt][i] = p; sum += p; } }
                    else s[kt][qt] = (f32x4){0.f, 0.f, 0.f, 0.f}; }
                sum += __shfl_xor(sum, 16); sum += __shfl_xor(sum, 32);
                inv[qt] = 1.0f / (sum + __expf(sink - m));
            }
            f32x4 o[4][2];
#pragma unroll
            for (int dt = 0; dt < 4; ++dt) { o[dt][0] = (f32x4){0.f, 0.f, 0.f, 0.f}; o[dt][1] = o[dt][0]; }
#pragma unroll
            for (int kk = 0; kk < 6; ++kk) if (kk * 32 < nvalid) {
                bf16x8 bp[2];
#pragma unroll
                for (int qt = 0; qt < 2; ++qt) { u32x4 t; t.x = pk2(s[2 * kk][qt][0], s[2 * kk][qt][1]); t.y = pk2(s[2 * kk][qt][2], s[2 * kk][qt][3]); t.z = pk2(s[2 * kk + 1][qt][0], s[2 * kk + 1][qt][1]); t.w = pk2(s[2 * kk + 1][qt][2], s[2 * kk + 1][qt][3]);
                    bp[qt] = __builtin_bit_cast(bf16x8, t); }
#pragma unroll
                for (int dt = 0; dt < 4; ++dt) { const LAS bf16* vp = Vt + (dt * 16 + fr) * 200 + kk * 32 + 4 * fq;
                    const u32x2 lo = *(const LAS u32x2*)vp, hi = *(const LAS u32x2*)(vp + 16); const u32x4 t = (u32x4){lo.x, lo.y, hi.x, hi.y}; const bf16x8 av = __builtin_bit_cast(bf16x8, t);
                    o[dt][0] = mfma16(av, bp[0], o[dt][0]); o[dt][1] = mfma16(av, bp[1], o[dt][1]); }
            }
#pragma unroll
            for (int qt = 0; qt < 2; ++qt) { const int tok = qh * 32 + qt * 16 + fr;
                if (tok < nq) { bf16* op = CAT + (size_t)(qrow0 + tok) * DM + (4 * kvh + hh) * 64 + 4 * fq;
#pragma unroll
                    for (int dt = 0; dt < 4; ++dt) { const f32x4 v = o[dt][qt] * inv[qt]; u32x2 wv; wv.x = pk2(v[0], v[1]); wv.y = pk2(v[2], v[3]); *(u32x2*)(op + dt * 16) = wv; } } }
        }
        __syncthreads();
    }
    const int gt = bid * NTHR + tid, NGT = G * NTHR;
    const float* scw = a.in[I_SCW];
    for (int it = gt; it < MV * 64; it += NGT) { const int row = it >> 6, ch = (it & 63) * 8;
        int t, L, bb; if (row < MPR) { bb = row >> 13; t = row & (SEQ - 1); L = SEQ; } else { bb = (row - MPR) >> 4; t = (row - MPR) & 15; L = 16; }
        float acc[8], uc[8];
#pragma unroll
        for (int j = 0; j < 8; ++j) acc[j] = 0.f;
#pragma unroll
        for (int d = 0; d < 3; ++d) {
            const int tt = t - 2 + d; float uu[8];
            if (tt >= 0) { const bf16* rp = P0 + (size_t)(row - 2 + d) * AB_IN; float gc[8], hx[8]; unpack8(*(const u32x4*)(rp + 1280 + ch), gc); unpack8(*(const u32x4*)(rp + 1792 + ch), hx);
#pragma unroll
                for (int j = 0; j < 8; ++j) uu[j] = gc[j] * hx[j]; }
            else if (row >= MPR) { const float* hp = a.in[I_SCONV] + ((size_t)bb * 2 + (2 + tt)) * 512 + ch;
#pragma unroll
                for (int j = 0; j < 8; ++j) uu[j] = hp[j]; }
            else {
#pragma unroll
                for (int j = 0; j < 8; ++j) uu[j] = 0.f; }
#pragma unroll
            for (int j = 0; j < 8; ++j) { acc[j] += scw[d * 512 + ch + j] * uu[j]; if (d == 2) uc[j] = uu[j]; }
        }
        float gb[8]; unpack8(*(const u32x4*)(P0 + (size_t)row * AB_IN + 768 + ch), gb);
#pragma unroll
        for (int j = 0; j < 8; ++j) acc[j] *= gb[j];
        *(u32x4*)(CAT + (size_t)row * DM + 512 + ch) = pack8(acc);
        if (t >= L - 2) { float* op = a.out + (row < MPR ? O_SCP + ((size_t)bb * 2 + (t - (L - 2))) * 512 : O_SCS + ((size_t)bb * 2 + (t - (L - 2))) * 512) + ch;
#pragma unroll
            for (int j = 0; j < 8; ++j) op[j] = uc[j]; }
    }
    for (int it = gt; it < (256 + 128) * 32; it += NGT) { const int ri = it >> 5, kvh = (it >> 4) & 1, dg = (it >> 1) & 7, isv = it & 1;
        int row, pos; float* op;
        if (ri < 256) { const int bb = ri >> 7, j = ri & 127; pos = SEQ - 128 + j; row = bb * SEQ + pos; op = a.out + (isv ? O_VP : O_KP) + ((size_t)(bb * 128 + j) * 2 + kvh) * 64 + dg * 8; }
        else { const int r2 = ri - 256, bb = r2 >> 4, j = r2 & 15; pos = 4096 + j; row = MPR + r2; op = a.out + (isv ? O_VS : O_KS) + ((size_t)(bb * 16 + j) * 2 + kvh) * 64 + dg * 8; }
        const bf16* rp = P0 + (size_t)row * AB_IN; float f[8];
        if (isv) unpack8(*(const u32x4*)(rp + 640 + kvh * 64 + dg * 8), f); else load8_rope(rp + 512 + kvh * 64, dg, rope + pos * 8, f);
        *(f32x4*)op = (f32x4){f[0], f[1], f[2], f[3]}; *(f32x4*)(op + 4) = (f32x4){f[4], f[5], f[6], f[7]};
    }
}

__device__ __forceinline__ void ssmconv_phase(const Args& a, int G, int bid) {
    const int tid = threadIdx.x, gt = bid * NTHR + tid, NGT = G * NTHR;
    bf16* XBC = (bf16*)(a.ws + WS_XBC); const bf16* HALO = (const bf16*)(a.ws + WS_HALO);
    const float* cw = a.in[I_SSMCW]; const float* cb = a.in[I_SSMCB];
    for (int it = gt; it < 264 * 384; it += NGT) {
        int cgp, r0, nrows; const bf16* hal = nullptr; const float* hist = nullptr; float* outc = nullptr;
        if (it < 256 * 384) { const int blk = it / 384; cgp = it - blk * 384; r0 = blk * 64; nrows = 64; if (blk & 127) hal = HALO + (size_t)(blk - 1) * 3 * XBCW; if ((blk & 127) == 127) outc = a.out + O_CCP + (size_t)(blk >> 7) * 3 * XBCW; }
        else { const int v = it - 256 * 384, bs = v / 384; cgp = v - bs * 384; r0 = MPR + bs * 16; nrows = 16; hist = a.in[I_SSMCONV] + (size_t)bs * 3 * XBCW; outc = a.out + O_CCS + (size_t)bs * 3 * XBCW; }
        const int col = cgp * 8;
        float h0[8], h1[8], h2[8], w0[8], w1[8], w2[8], w3[8], bz[8];
#pragma unroll
        for (int j = 0; j < 8; ++j) { h0[j] = 0.f; h1[j] = 0.f; h2[j] = 0.f; w0[j] = cw[col + j]; w1[j] = cw[XBCW + col + j]; w2[j] = cw[2 * XBCW + col + j]; w3[j] = cw[3 * XBCW + col + j]; bz[j] = cb[col + j]; }
        if (hal) { unpack8(*(const u32x4*)(hal + col), h0); unpack8(*(const u32x4*)(hal + XBCW + col), h1); unpack8(*(const u32x4*)(hal + 2 * XBCW + col), h2); }
        if (hist) {
#pragma unroll
            for (int j = 0; j < 8; ++j) { h0[j] = hist[col + j]; h1[j] = hist[XBCW + col + j]; h2[j] = hist[2 * XBCW + col + j]; } }
        bf16* p = XBC + (size_t)r0 * XBCW + col;
        for (int r = 0; r < nrows; r += 4) {
            u32x4 raw[4];
#pragma unroll
            for (int q = 0; q < 4; ++q) raw[q] = *(const u32x4*)(p + (size_t)(r + q) * XBCW);
#pragma unroll
            for (int q = 0; q < 4; ++q) { float cur[8], y[8]; unpack8(raw[q], cur);
#pragma unroll
                for (int j = 0; j < 8; ++j) { y[j] = silu(w0[j] * h0[j] + w1[j] * h1[j] + w2[j] * h2[j] + w3[j] * cur[j] + bz[j]); h0[j] = h1[j]; h1[j] = h2[j]; h2[j] = cur[j]; }
                *(u32x4*)(p + (size_t)(r + q) * XBCW) = pack8(y); }
        }
        if (outc) {
#pragma unroll
            for (int j = 0; j < 8; ++j) { outc[col + j] = h0[j]; outc[XBCW + col + j] = h1[j]; outc[2 * XBCW + col + j] = h2[j]; } }
    }
    float* DT = (float*)(a.ws + WS_DT); const float* dtb = a.in[I_DTB];
    for (int it = gt; it < MV * 32; it += NGT) { const float x = DT[it] + dtb[it & 31]; const float e = __expf(x);
        DT[it] = x > 20.f ? x : (e < 1e-2f ? e * (1.f - e * (0.5f - e * 0.33333333f)) : __logf(1.f + e)); }
}

constexpr int S_XT = 0, S_XW = 9216, S_BM = 18432, S_BT = 35840, S_CM = 54272, S_HA = 71680, S_SC = 89088;
template <bool FULL>
__device__ __forceinline__ void ssd_stream(const Args& a, LAS unsigned char* lds, f32x4 (&st)[2][2], const int row0, const int nchunks, const int nvalid, const int h, const float a_h, const float d_h, float& logdec) {
    LAS bf16* xT = (LAS bf16*)(lds + S_XT); LAS bf16* xwT = (LAS bf16*)(lds + S_XW); LAS bf16* Bm = (LAS bf16*)(lds + S_BM); LAS bf16* BT = (LAS bf16*)(lds + S_BT);
    LAS bf16* Cm = (LAS bf16*)(lds + S_CM); LAS bf16* HA = (LAS bf16*)(lds + S_HA); LAS float* scal0 = (LAS float*)(lds + S_SC);
    const int tid = threadIdx.x, lane = tid & 63, w = tid >> 6, fr = lane & 15, fq = lane >> 4, nq4 = w & 3, pr = w >> 2, g = h >> 3, lt = w & 3;
    const bf16* XBC = (const bf16*)(a.ws + WS_XBC); bf16* Z = (bf16*)(a.ws + WS_Z); const float* DT = (const float*)(a.ws + WS_DT);
    u32x4 px, pb[2], pc[2]; float pdt = 0.f;
    const u32x4 zero4 = (u32x4){0u, 0u, 0u, 0u};
    const bool lv = lane < nvalid;
#define SSD_PREFETCH(ci) do { const bf16* rp_ = XBC + (size_t)(row0 + 64 * (ci) + lane) * XBCW; \
        px = lv ? *(const u32x4*)(rp_ + h * 64 + w * 8) : zero4; \
        _Pragma("unroll") for (int k_ = 0; k_ < 2; ++k_) { pb[k_] = lv ? *(const u32x4*)(rp_ + 2048 + g * 128 + (w + 8 * k_) * 8) : zero4; \
            if (FULL) pc[k_] = lv ? *(const u32x4*)(rp_ + 2560 + g * 128 + (w + 8 * k_) * 8) : zero4; } } while (0)
#define SSD_DTLOAD(ci) do { pdt = (lv && (ci) < nchunks) ? DT[(size_t)(row0 + 64 * (ci) + lane) * 32 + h] : 0.f; } while (0)
#define SSD_SCAN(buf) do { LAS float* sc_ = scal0 + 320 * (buf); const float dtl_ = pdt; float v_ = dtl_ * a_h; \
        _Pragma("unroll") for (int o_ = 1; o_ < 64; o_ <<= 1) { const float t_ = __shfl_up(v_, o_); if (lane >= o_) v_ += t_; } \
        const float tot_ = __shfl(v_, 63); sc_[lane] = v_; sc_[64 + lane] = __expf(v_); sc_[128 + lane] = __expf(tot_ - v_) * dtl_; sc_[192 + lane] = dtl_; if (lane == 0) sc_[256] = tot_; } while (0)
    SSD_PREFETCH(0);
    if (w == 0) { SSD_DTLOAD(0); SSD_SCAN(0); SSD_DTLOAD(1); }
    __syncthreads();
    for (int ci = 0; ci < nchunks; ++ci) {
        const int rbase = row0 + 64 * ci;
        LAS float* scal = scal0 + 320 * (ci & 1);
        { const float dte = scal[128 + lane]; float f[8]; unpack8(px, f);
          LAS bf16* p1 = xT + (w * 8) * 72 + lane; LAS bf16* p2 = xwT + (w * 8) * 72 + lane;
#pragma unroll
          for (int j = 0; j < 8; ++j) { p1[j * 72] = f2bf(f[j]); p2[j * 72] = f2bf(f[j] * dte); } }
#pragma unroll
        for (int k = 0; k < 2; ++k) { const int ng = w + 8 * k;
            *(LAS u32x4*)(Bm + lane * 136 + ng * 8) = pb[k];
            LAS bf16* bp = BT + (ng * 8) * 72 + lane; const u32x4 v = pb[k];
            bp[0 * 72] = (bf16)(v.x & 0xffffu); bp[1 * 72] = (bf16)(v.x >> 16); bp[2 * 72] = (bf16)(v.y & 0xffffu); bp[3 * 72] = (bf16)(v.y >> 16);
            bp[4 * 72] = (bf16)(v.z & 0xffffu); bp[5 * 72] = (bf16)(v.z >> 16); bp[6 * 72] = (bf16)(v.w & 0xffffu); bp[7 * 72] = (bf16)(v.w >> 16);
            if (FULL) *(LAS u32x4*)(Cm + lane * 136 + ng * 8) = pc[k]; }
        if (FULL) {
#pragma unroll
            for (int nt = 0; nt < 2; ++nt)
#pragma unroll
                for (int pt = 0; pt < 2; ++pt) { const f32x4 v = st[nt][pt]; u32x2 wv; wv.x = pk2(v[0], v[1]); wv.y = pk2(v[2], v[3]);
                    *(LAS u32x2*)(HA + (32 * pr + 16 * pt + fr) * 136 + 32 * nq4 + 16 * nt + 4 * fq) = wv; } }
        if (ci + 1 < nchunks) SSD_PREFETCH(ci + 1);
        __syncthreads();
        if (w == 0 && ci + 1 < nchunks) { SSD_SCAN((ci + 1) & 1); SSD_DTLOAD(ci + 2); }
        u32x2 zr[2]; const int l = 16 * lt + fr;
        if (FULL) {
#pragma unroll
            for (int k2 = 0; k2 < 2; ++k2) { zr[k2] = (u32x2){0u, 0u}; if (l < nvalid) zr[k2] = *(const u32x2*)(Z + (size_t)(rbase + l) * ZW + h * 64 + 16 * (2 * pr + k2) + 4 * fq); } }
        { const float tot = scal[256]; logdec += tot; const float dec = __expf(tot);
#pragma unroll
          for (int nt = 0; nt < 2; ++nt)
#pragma unroll
              for (int pt = 0; pt < 2; ++pt) st[nt][pt] = st[nt][pt] * dec;
#pragma unroll
          for (int ks = 0; ks < 2; ++ks) { bf16x8 af[2], bx[2];
#pragma unroll
              for (int t = 0; t < 2; ++t) { af[t] = *(const LAS bf16x8*)(BT + (32 * nq4 + 16 * t + fr) * 72 + ks * 32 + fq * 8); bx[t] = *(const LAS bf16x8*)(xwT + (32 * pr + 16 * t + fr) * 72 + ks * 32 + fq * 8); }
#pragma unroll
              for (int nt = 0; nt < 2; ++nt)
#pragma unroll
                  for (int pt = 0; pt < 2; ++pt) st[nt][pt] = mfma16(af[nt], bx[pt], st[nt][pt]); } }
        if (FULL) {
            bf16x8 cf[4];
#pragma unroll
            for (int ks = 0; ks < 4; ++ks) cf[ks] = *(const LAS bf16x8*)(Cm + l * 136 + ks * 32 + fq * 8);
            const float al = scal[l];
            unsigned wpk[4][2];
#pragma unroll
            for (int s4 = 0; s4 < 4; ++s4) {
                wpk[s4][0] = 0u; wpk[s4][1] = 0u;
                if (s4 <= lt) { f32x4 acc = (f32x4){0.f, 0.f, 0.f, 0.f};
#pragma unroll
                    for (int ks = 0; ks < 4; ++ks) { const bf16x8 af = *(const LAS bf16x8*)(Bm + (16 * s4 + fr) * 136 + ks * 32 + fq * 8); acc = mfma16(af, cf[ks], acc); }
                    const f32x4 as = *(const LAS f32x4*)(scal + 16 * s4 + 4 * fq), ds = *(const LAS f32x4*)(scal + 192 + 16 * s4 + 4 * fq); float v[4];
#pragma unroll
                    for (int i = 0; i < 4; ++i) { const int s = 16 * s4 + 4 * fq + i; v[i] = s <= l ? acc[i] * __expf(al - as[i]) * ds[i] : 0.f; }
                    wpk[s4][0] = pk2(v[0], v[1]); wpk[s4][1] = pk2(v[2], v[3]); }
            }
            bf16x8 bw[2];
#pragma unroll
            for (int ks = 0; ks < 2; ++ks) { const u32x4 t = (u32x4){wpk[2 * ks][0], wpk[2 * ks][1], wpk[2 * ks + 1][0], wpk[2 * ks + 1][1]}; bw[ks] = __builtin_bit_cast(bf16x8, t); }
            const float e = scal[64 + l];
#pragma unroll
            for (int k2 = 0; k2 < 2; ++k2) { const int pt = 2 * pr + k2;
                f32x4 dg = (f32x4){0.f, 0.f, 0.f, 0.f}, of = dg;
#pragma unroll
                for (int ks = 0; ks < 2; ++ks) { const LAS bf16* xp = xT + (16 * pt + fr) * 72 + ks * 32 + 4 * fq; const u32x2 lo = *(const LAS u32x2*)xp, hi = *(const LAS u32x2*)(xp + 16);
                    const u32x4 t = (u32x4){lo.x, lo.y, hi.x, hi.y}; dg = mfma16(__builtin_bit_cast(bf16x8, t), bw[ks], dg); }
#pragma unroll
                for (int ks = 0; ks < 4; ++ks) { const bf16x8 af = *(const LAS bf16x8*)(HA + (16 * pt + fr) * 136 + ks * 32 + fq * 8); of = mfma16(af, cf[ks], of); }
                const float zf[4] = {bflo(zr[k2].x), bfhi(zr[k2].x), bflo(zr[k2].y), bfhi(zr[k2].y)}; float y[4];
#pragma unroll
                for (int i = 0; i < 4; ++i) { const float xv = bf1(xT[(16 * pt + 4 * fq + i) * 72 + l]); y[i] = (dg[i] + of[i] * e + d_h * xv) * silu(zf[i]); }
                if (l < nvalid) { u32x2 wv; wv.x = pk2(y[0], y[1]); wv.y = pk2(y[2], y[3]); *(u32x2*)(Z + (size_t)(rbase + l) * ZW + h * 64 + 16 * pt + 4 * fq) = wv; } }
        }
        __syncthreads();
    }
#undef SSD_PREFETCH
#undef SSD_DTLOAD
#undef SSD_SCAN
}
__device__ __forceinline__ void ssd_pass_a(const Args& a, LAS unsigned char* lds, int G, int bid) {
    const int tid = threadIdx.x;
    float* SEG = (float*)(a.ws + WS_SEG); float* SEGD = (float*)(a.ws + WS_SEGD);
    for (int u = bid; u < 192; u += G) { const int bh = u / 3, seg = u - bh * 3, b = bh >> 5, h = bh & 31;
        f32x4 st[2][2];
#pragma unroll
        for (int i = 0; i < 2; ++i) { st[i][0] = (f32x4){0.f, 0.f, 0.f, 0.f}; st[i][1] = st[i][0]; }
        float logdec = 0.f; const float a_h = -__expf(a.in[I_ALOG][h]);
        ssd_stream<false>(a, lds, st, b * SEQ + seg * 2048, 32, 64, h, a_h, 0.f, logdec);
        f32x4* sp = (f32x4*)(SEG + (size_t)u * 8192);
#pragma unroll
        for (int i = 0; i < 2; ++i)
#pragma unroll
            for (int j = 0; j < 2; ++j) sp[(i * 2 + j) * NTHR + tid] = st[i][j];
        if (tid == 0) SEGD[u] = logdec;
    }
}
__device__ __forceinline__ void ssd_pass_b(const Args& a, LAS unsigned char* lds, int G, int bid) {
    const int tid = threadIdx.x, lane = tid & 63, w = tid >> 6, fr = lane & 15, fq = lane >> 4, nq4 = w & 3, pr = w >> 2;
    const float* SEG = (const float*)(a.ws + WS_SEG); const float* SEGD = (const float*)(a.ws + WS_SEGD);
    for (int u = bid; u < 512; u += G) {
        f32x4 st[2][2]; float logdec = 0.f;
        if (u < 256) { const int bh = u >> 2, seg = u & 3, b = bh >> 5, h = bh & 31;
#pragma unroll
            for (int i = 0; i < 2; ++i) { st[i][0] = (f32x4){0.f, 0.f, 0.f, 0.f}; st[i][1] = st[i][0]; }
            for (int s = 0; s < seg; ++s) { const float dec = __expf(SEGD[bh * 3 + s]); const f32x4* sp = (const f32x4*)(SEG + (size_t)(bh * 3 + s) * 8192);
#pragma unroll
                for (int i = 0; i < 2; ++i)
#pragma unroll
                    for (int j = 0; j < 2; ++j) st[i][j] = st[i][j] * dec + sp[(i * 2 + j) * NTHR + tid]; }
            const float a_h = -__expf(a.in[I_ALOG][h]), d_h = a.in[I_SSMD][h];
            ssd_stream<true>(a, lds, st, b * SEQ + seg * 2048, 32, 64, h, a_h, d_h, logdec);
            if (seg == 3) { float* op = a.out + O_SSP + (size_t)bh * 8192;
#pragma unroll
                for (int nt = 0; nt < 2; ++nt)
#pragma unroll
                    for (int pt = 0; pt < 2; ++pt) *(f32x4*)(op + (32 * pr + 16 * pt + fr) * 128 + 32 * nq4 + 16 * nt + 4 * fq) = st[nt][pt]; }
        } else { const int v = u - 256, bs = v >> 5, h = v & 31;
            const float* ip = a.in[I_SSM] + (size_t)v * 8192;
#pragma unroll
            for (int nt = 0; nt < 2; ++nt)
#pragma unroll
                for (int pt = 0; pt < 2; ++pt) st[nt][pt] = *(const f32x4*)(ip + (32 * pr + 16 * pt + fr) * 128 + 32 * nq4 + 16 * nt + 4 * fq);
            const float a_h = -__expf(a.in[I_ALOG][h]), d_h = a.in[I_SSMD][h];
            ssd_stream<true>(a, lds, st, MPR + bs * 16, 1, 16, h, a_h, d_h, logdec);
            float* op = a.out + O_SSS + (size_t)v * 8192;
#pragma unroll
            for (int nt = 0; nt < 2; ++nt)
#pragma unroll
                for (int pt = 0; pt < 2; ++pt) *(f32x4*)(op + (32 * pr + 16 * pt + fr) * 128 + 32 * nq4 + 16 * nt + 4 * fq) = st[nt][pt];
        }
    }
}
__device__ __forceinline__ void gnorm_phase(const Args& a, int G, int bid) {
    const int tid = threadIdx.x, lane = tid & 63, wave = tid >> 6, gw = bid * NWAVES + wave, NGW = G * NWAVES;
    bf16* Z = (bf16*)(a.ws + WS_Z); const float* ng = a.in[I_SSMNG];
    for (int it = gw; it < MV * 4; it += NGW) { const int row = it >> 2, g = it & 3;
        u32x4* p = (u32x4*)(Z + (size_t)row * ZW + g * 512 + lane * 8); float f[8]; unpack8(*p, f);
        float ss = 0.f;
#pragma unroll
        for (int j = 0; j < 8; ++j) ss += f[j] * f[j];
        const float r = __builtin_amdgcn_rsqf(wave_sum(ss) * (1.f / 512.f) + EPS);
        const f32x4 g0 = *(const f32x4*)(ng + g * 512 + lane * 8), g1 = *(const f32x4*)(ng + g * 512 + lane * 8 + 4);
        f[0] *= r * g0.x; f[1] *= r * g0.y; f[2] *= r * g0.z; f[3] *= r * g0.w; f[4] *= r * g1.x; f[5] *= r * g1.y; f[6] *= r * g1.z; f[7] *= r * g1.w;
        *p = pack8(f); }
}


__device__ __forceinline__ void sample_gemm(const bf16* A, const bf16* Bt, int K, bf16* out, LAS unsigned char* lds, int bid) {
    if (bid >= 64) return;
    const int tid = threadIdx.x, lane = tid & 63, w = tid >> 6, fr = lane & 15, fq = lane >> 4;
    const int row0 = MPR + 32 * (bid & 3), col0 = 64 * (bid >> 2), ksl = K >> 3, nst = ksl >> 5;
    const bf16* ap = A + (size_t)(row0 + fr) * K + w * ksl + 8 * fq;
    const bf16* bp = Bt + (size_t)(col0 + fr) * K + w * ksl + 8 * fq;
    f32x4 acc[2][4];
#pragma unroll
    for (int t = 0; t < 2; ++t)
#pragma unroll
        for (int c = 0; c < 4; ++c) acc[t][c] = (f32x4){0.f, 0.f, 0.f, 0.f};
    for (int s0 = 0; s0 < nst; s0 += 4) {
        bf16x8 af[4][2], bfm[4][4];
#pragma unroll
        for (int s = 0; s < 4; ++s) if (s0 + s < nst) {
#pragma unroll
            for (int t = 0; t < 2; ++t) af[s][t] = *(const bf16x8*)(ap + (size_t)(16 * t) * K + 32 * (s0 + s));
#pragma unroll
            for (int c = 0; c < 4; ++c) bfm[s][c] = *(const bf16x8*)(bp + (size_t)(16 * c) * K + 32 * (s0 + s)); }
#pragma unroll
        for (int s = 0; s < 4; ++s) if (s0 + s < nst) {
#pragma unroll
            for (int t = 0; t < 2; ++t)
#pragma unroll
                for (int c = 0; c < 4; ++c) acc[t][c] = mfma16(bfm[s][c], af[s][t], acc[t][c]); }
    }
    LAS f32x4* red = (LAS f32x4*)lds;
#pragma unroll
    for (int t = 0; t < 2; ++t)
#pragma unroll
        for (int c = 0; c < 4; ++c) red[(w * 8 + t * 4 + c) * 64 + lane] = acc[t][c];
    __syncthreads();
    f32x4 sum = red[w * 64 + lane];
#pragma unroll
    for (int v = 1; v < 8; ++v) sum = sum + red[(v * 8 + w) * 64 + lane];
    u32x2 wv; wv.x = pk2(sum[0], sum[1]); wv.y = pk2(sum[2], sum[3]);
    *(u32x2*)(out + (size_t)(row0 + 16 * (w >> 2) + fr) * DM + col0 + 16 * (w & 3) + 4 * fq) = wv;
    __syncthreads();
}

#define XB_TMO      128
#define XB_XCNT(j)  (256  + 64 * (j))
#define XB_XSUB(j)  (1280 + 64 * (j))
#define XB_XGEN(j)  (2304 + 64 * (j))
#define XB_TOP      3328
#define XB_TOPGEN   3392
#define XCD_BAR_WORDS 3456
#define XB_SPIN_CAP (1u << 18)

__device__ __forceinline__ unsigned xb_ld(unsigned* p)              { return __hip_atomic_load(p, __ATOMIC_RELAXED, __HIP_MEMORY_SCOPE_AGENT); }
__device__ __forceinline__ unsigned xb_add(unsigned* p, unsigned v) { return __hip_atomic_fetch_add(p, v, __ATOMIC_RELAXED, __HIP_MEMORY_SCOPE_AGENT); }
__device__ __forceinline__ unsigned xb_xcc_id() { return (unsigned)__builtin_amdgcn_s_getreg((3 << 11) | 20) & 0xFu; }
#define XB_SPIN(cond, bar) do { unsigned _sp = 0; while (cond) { __builtin_amdgcn_s_sleep(1); \
    if ((++_sp & 255u) == 0u) { if (xb_ld(&(bar)[XB_TMO])) break; if (_sp > XB_SPIN_CAP) { atomicAdd(&(bar)[XB_TMO], 1u); break; } } } } while (0)

struct XcdBarrier {
    unsigned* bar; unsigned x;
    volatile LAS unsigned* st;
};

__device__ __forceinline__ XcdBarrier xcd_barrier_post(unsigned* bar, volatile LAS unsigned* st) {
    XcdBarrier b; b.bar = bar; b.x = xb_xcc_id(); b.st = st;
    if (threadIdx.x == 0) (void)xb_add(&bar[XB_XCNT(b.x)], 1u);
    return b;
}
__device__ __forceinline__ void xcd_barrier_complete(unsigned* bar, unsigned x, unsigned& nloc, unsigned& nx) {
    const unsigned G = gridDim.x * gridDim.y * gridDim.z;
    unsigned sum, cnt, mine, sp = 0u;
    for (;;) {
        sum = 0u; cnt = 0u; mine = 0u;
#pragma unroll
        for (unsigned j = 0; j < 16; ++j) { const unsigned c = xb_ld(&bar[XB_XCNT(j)]); sum += c; cnt += (c > 0u) ? 1u : 0u; mine = (j == x) ? c : mine; }
        if (sum == G) break;
        __builtin_amdgcn_s_sleep(1);
        if ((++sp & 255u) == 0u) { if (xb_ld(&bar[XB_TMO])) break; if (sp > XB_SPIN_CAP) { atomicAdd(&bar[XB_TMO], 1u); break; } }
    }
    nloc = mine > 0u ? mine : 1u; nx = cnt > 0u ? cnt : 1u;
}

__device__ __forceinline__ void xcd_barrier(const XcdBarrier& b) {
    asm volatile("s_waitcnt vmcnt(0)" ::: "memory");
    __syncthreads();
    if (threadIdx.x == 0) {
        unsigned* bar = b.bar;
        __builtin_amdgcn_s_waitcnt(0);
        unsigned nloc = b.st[0], nx = b.st[1];
        if (nloc == 0u) { xcd_barrier_complete(bar, b.x, nloc, nx); b.st[0] = nloc; b.st[1] = nx; }
        const unsigned old = xb_add(&bar[XB_XSUB(b.x)], 1u);
        const unsigned gen = old / nloc;
        if (old + 1u == (gen + 1u) * nloc) {
            __builtin_amdgcn_fence(__ATOMIC_RELEASE, "agent");
            asm volatile("s_waitcnt vmcnt(0)" ::: "memory");
            const unsigned og = xb_add(&bar[XB_TOP], 1u);
            const unsigned tg = og / nx;
            if (og + 1u == (tg + 1u) * nx) xb_add(&bar[XB_TOPGEN], 1u);
            else XB_SPIN(xb_ld(&bar[XB_TOPGEN]) == tg, bar);
            __builtin_amdgcn_fence(__ATOMIC_ACQUIRE, "agent");
            xb_add(&bar[XB_XGEN(b.x)], 1u);
            asm volatile("s_waitcnt vmcnt(0)" ::: "memory");
        } else {
            XB_SPIN(xb_ld(&bar[XB_XGEN(b.x)]) == gen, bar);
            __builtin_amdgcn_fence(__ATOMIC_ACQUIRE, "agent");
            asm volatile("s_waitcnt vmcnt(0)" ::: "memory");
        }
    }
    __syncthreads();
}

#ifndef MK_ONE_LAUNCH
#define MK_ONE_LAUNCH 1
#endif
constexpr int N_PHASES = 18;
__global__ void __launch_bounds__(NTHR, 2) mega_fwd(Args args) {
    extern __shared__ __attribute__((aligned(16))) unsigned char lds_raw[];
    LAS unsigned char* lds = (LAS unsigned char*)lds_raw;
    cg::grid_group grid = cg::this_grid();
    volatile LAS unsigned* MISC = (volatile LAS unsigned*)(lds + 131072 + 320);
    if (threadIdx.x < 32) MISC[threadIdx.x] = 0u;
    __syncthreads();
    XcdBarrier bar = xcd_barrier_post((unsigned*)(args.ws + WS_BAR), MISC + 8);
    if (args.ph_lo > args.ph_hi) grid.sync();
    const int G = gridDim.x, bid = blockIdx.x;
    unsigned char* ws = args.ws;
    const int lo = args.ph_lo, hi = args.ph_hi;
    const float* NG = args.in[I_NG];
    bf16* XN = (bf16*)(ws + WS_XN); bf16* MIX = (bf16*)(ws + WS_MIX); bf16* HB = (bf16*)(ws + WS_H);
#ifndef PROBE_DBL
#define PROBE_DBL 0
#endif
#define IN(k) (lo <= (k) && (k) < hi)
#define PH(k, ...) if (IN(k)) { __VA_ARGS__ if ((PROBE_DBL >> (k)) & 1) { __VA_ARGS__ } }
#define SEAM(k) do { if (IN(k) && IN((k) + 1)) xcd_barrier(bar); } while (0)
#define GEMM_SPLIT(Aptr, Wptr, NN, KK, E) do { pg8::Gemm g_{(const pg8::bf16_t*)(Aptr), (const pg8::bf16_t*)(Wptr), MPAD, (NN), (KK)}; pg8::StaticOrder S_; S_.init(MPAD, (NN), G, bid); \
        pg8::gemm_phase<pg8::EpiSplit, pg8::StaticOrder, true, true>(lds, g_, S_, E); } while (0)
#define GEMM_N1024(Aptr, Wptr, KK) do { pg8::EpiSplit E_{MIX, DM, DM, nullptr, 0, DM, nullptr, 0, nullptr}; pg8::Gemm g_{(const pg8::bf16_t*)(Aptr), (const pg8::bf16_t*)(Wptr), MPR, DM, (KK)}; pg8::StaticOrder S_; S_.init(MPR, DM, G, bid); \
        pg8::gemm_phase<pg8::EpiSplit, pg8::StaticOrder, true, true>(lds, g_, S_, E_); sample_gemm((const bf16*)(Aptr), (const bf16*)(Wptr), (KK), MIX, lds, bid); } while (0)
#define GEMM_SWIGLU(Aptr, Wptr, E) do { pg8::Gemm g_{(const pg8::bf16_t*)(Aptr), (const pg8::bf16_t*)(Wptr), MPAD, 2 * DFF, DM}; pg8::StaticOrder S_; S_.init(MPAD, 2 * DFF, G, bid); \
        pg8::gemm_phase<pg8::EpiSwiGLU, pg8::StaticOrder, true, true>(lds, g_, S_, E); } while (0)
    PH(0, p0_prologue(args, lds, G, bid);) SEAM(0);
    PH(1, pg8::EpiSplit E{(bf16*)(ws + WS_P0), AB_IN, AB_IN, nullptr, 0, AB_IN, nullptr, 0, nullptr}; GEMM_SPLIT(XN, ws + WS_W_ABIN, AB_IN, DM, E);) SEAM(1);
    PH(2, attn_phase(args, lds, G, bid);) SEAM(2);
    PH(3, GEMM_N1024(ws + WS_CAT, ws + WS_W_ABOUT, DM);) SEAM(3);
    PH(4, nrn_rows<true, true>(args, NG + 1 * DM, NG + 2 * DM, G, bid);) SEAM(4);
    PH(5, pg8::EpiSwiGLU E{HB, DFF}; GEMM_SWIGLU(XN, ws + WS_W_UP0, E);) SEAM(5);
    PH(6, GEMM_N1024(HB, ws + WS_W_DN0, DFF);) SEAM(6);
    PH(7, nrn_rows<true>(args, NG + 3 * DM, NG + 4 * DM, G, bid);) SEAM(7);
    PH(8, pg8::EpiSplit E{(bf16*)(ws + WS_Z), ZW, ZW, (bf16*)(ws + WS_XBC), XBCW, ZW + XBCW, (float*)(ws + WS_DT), 32, (bf16*)(ws + WS_HALO)}; GEMM_SPLIT(XN, ws + WS_W_SSMIN, SSM_INP, DM, E);) SEAM(8);
    PH(9, ssmconv_phase(args, G, bid);) SEAM(9);
    PH(10, ssd_pass_a(args, lds, G, bid);) SEAM(10);
    PH(11, ssd_pass_b(args, lds, G, bid);) SEAM(11);
    PH(12, gnorm_phase(args, G, bid);) SEAM(12);
    PH(13, GEMM_N1024(ws + WS_Z, ws + WS_W_SSMOUT, ZW);) SEAM(13);
    PH(14, nrn_rows<true>(args, NG + 5 * DM, NG + 6 * DM, G, bid);) SEAM(14);
    PH(15, pg8::EpiSwiGLU E{HB, DFF}; GEMM_SWIGLU(XN, ws + WS_W_UP1, E);) SEAM(15);
    PH(16, GEMM_N1024(HB, ws + WS_W_DN1, DFF);) SEAM(16);
    PH(17, nrn_rows<false>(args, NG + 7 * DM, NG + 7 * DM, G, bid);)
#undef IN
#undef SEAM
}

extern "C" void kernel_launch(void* const* d_in, const int* in_sizes, int n_in, void* d_out, int out_size, void* d_ws, size_t ws_size, hipStream_t stream) {
    static int grid = 0;
    if (grid == 0) {
        if (n_in != 23 || out_size != (int)O_END || ws_size < WS_END) { fprintf(stderr, "kernel_launch: unexpected shapes (n_in %d out %d ws %zu)\n", n_in, out_size, ws_size); grid = -1; return; }
        int dev = 0, cus = 0, per_cu = 0;
        (void)hipGetDevice(&dev); (void)hipDeviceGetAttribute(&cus, hipDeviceAttributeMultiprocessorCount, dev);
        if (hipFuncSetAttribute((const void*)mega_fwd, hipFuncAttributeMaxDynamicSharedMemorySize, LDS_BYTES) != hipSuccess) { fprintf(stderr, "kernel_launch: hipFuncSetAttribute failed\n"); grid = -1; return; }
        if (hipOccupancyMaxActiveBlocksPerMultiprocessor(&per_cu, (const void*)mega_fwd, NTHR, LDS_BYTES) != hipSuccess || per_cu < 1) { fprintf(stderr, "kernel_launch: occupancy query gave %d\n", per_cu); per_cu = 1; }
        (void)hipGetLastError();
        grid = cus * 1;
        if (grid <= 0) grid = 256;
    }
    if (grid < 0) return;
    Args a{};
    for (int i = 0; i < 23; ++i) a.in[i] = (const float*)d_in[i];
    a.out = (float*)d_out; a.ws = (unsigned char*)d_ws;
    if (hipMemsetAsync((char*)d_ws + WS_BAR, 0, BAR_BYTES, stream) != hipSuccess) { fprintf(stderr, "kernel_launch: memset failed\n"); return; }
#if MK_ONE_LAUNCH
    a.ph_lo = 0; a.ph_hi = N_PHASES;
    void* kargs[] = {&a};
    hipError_t e = hipLaunchCooperativeKernel((const void*)mega_fwd, dim3(grid), dim3(NTHR), kargs, LDS_BYTES, stream);
    if (e != hipSuccess) fprintf(stderr, "kernel_launch: cooperative launch failed: %s (grid %d)\n", hipGetErrorString(e), grid);
#else
    for (int p = 0; p < N_PHASES; ++p) { a.ph_lo = p; a.ph_hi = p + 1; hipLaunchKernelGGL(mega_fwd, dim3(grid), dim3(NTHR), LDS_BYTES, stream, a); }
#endif
}
```

```cpp
#include <hip/hip_runtime.h>
#include <hip/hip_cooperative_groups.h>
#include <cstdio>
#include <cstdint>
namespace cg = cooperative_groups;
#define MK_ONE_LAUNCH 1
namespace pg8 {
#define PG8_LAS __attribute__((address_space(3)))
typedef unsigned short bf16_t;
typedef short bf16x8 __attribute__((ext_vector_type(8)));
typedef float f32x4 __attribute__((ext_vector_type(4)));
typedef unsigned u32x4 __attribute__((ext_vector_type(4)));
constexpr int BM = 256, BK = 64, HALF = 128, HTB = HALF * BK * 2  , STAGE_BYTES = 8 * HTB, NXCD = 8, WGM = 8;

__host__ __device__ __forceinline__ int lds_byte(int r, int c) { const int st = (r >> 4) * 2 + (c >> 5), rr = r & 15, cc = c & 31, ob = rr * 64 + cc * 2; return st * 1024 + (ob ^ (((ob >> 9) & 1) << 5)); }
__host__ __device__ __forceinline__ void stage_rc(int b, int& R, int& C) { const int st = b / 1024, sb = b % 1024, swz = sb ^ (((sb >> 9) & 1) << 5); R = (st >> 1) * 16 + swz / 64; C = (st & 1) * 32 + (swz % 64) / 2; }
__host__ __device__ __forceinline__ int perm32(int rho) { const int n = rho >> 4, i = rho & 15; return 8 * (i >> 2) + 4 * n + (i & 3); }

struct Unit { int pm, pn; };
struct Gemm { const bf16_t* A; const bf16_t* Bt; int M, N, K; };

struct StaticOrder {
    int nM, nN, nwg, G, c;
    __host__ __device__ void init(int M, int N, int G_, int c_) { nM = M / BM; nN = N / BM; nwg = nM * nN; G = G_; c = c_; }
    __host__ __device__ bool next(int i, Unit& u) const {
        const long L = (long)i * G + c; if (L >= nwg) return false;
        int wgid = (int)L; { const int q = nwg / NXCD, r = nwg % NXCD, xcd = wgid % NXCD, off = wgid / NXCD; wgid = (xcd < r ? xcd * (q + 1) : r * (q + 1) + (xcd - r) * q) + off; }
        const int nig = WGM * nN, gid = wgid / nig, fm = gid * WGM, gsz = (nM - fm) < WGM ? (nM - fm) : WGM;
        u.pm = fm + ((wgid % nig) % gsz); u.pn = (wgid % nig) / gsz; return true;
    }
    __device__ __forceinline__ void a_ready(const Unit&) const {}
    __device__ __forceinline__ void done(const Unit&) const {}
};

__device__ __forceinline__ unsigned cvt_pk_bf16(float lo, float hi) { unsigned r; asm volatile("v_cvt_pk_bf16_f32 %0, %1, %2" : "=v"(r) : "v"(lo), "v"(hi)); return r; }
__device__ __forceinline__ float silu_f(float v) { return v * __builtin_amdgcn_rcpf(1.0f + __expf(-v)); }
struct EpiSplit {
    static constexpr bool PERM = true, AFTER_DRAIN = false;
    bf16_t* O0; int ld0; int c1; bf16_t* O1; int ld1; int c2; float* O2; int ld2; bf16_t* halo;
    __device__ __forceinline__ void operator()(const f32x4 (&acc)[2][2][4][2], const Unit& u, int wr, int wc, int fr, int fq) const {
        const int row0 = u.pm * BM + wr * 64 + fr; const int colt = u.pn * BM;
        if (colt >= c2) {
            if (wc == 0) {
#pragma unroll
                for (int ai = 0; ai < 2; ++ai)
#pragma unroll
                    for (int m = 0; m < 4; ++m) { float* rp = O2 + (size_t)(row0 + ai * HALF + m * 16) * ld2 + 8 * fq; *(f32x4*)rp = acc[ai][0][m][0]; *(f32x4*)(rp + 4) = acc[ai][0][m][1]; }
            }
            return;
        }
        bf16_t* base; int ld, cb; bool hal = false;
        if (colt < c1) { base = O0; ld = ld0; cb = colt; } else { base = O1; ld = ld1; cb = colt - c1; hal = (halo != nullptr); }
        const int col0 = cb + wc * 32 + 8 * fq;
#pragma unroll
        for (int ai = 0; ai < 2; ++ai)
#pragma unroll
            for (int m = 0; m < 4; ++m) { const int r = row0 + ai * HALF + m * 16; bf16_t* rowp = base + (size_t)r * ld + col0;
#pragma unroll
                for (int bj = 0; bj < 2; ++bj) { const f32x4 v0 = acc[ai][bj][m][0], v1 = acc[ai][bj][m][1];
                    u32x4 w; w.x = cvt_pk_bf16(v0[0], v0[1]); w.y = cvt_pk_bf16(v0[2], v0[3]); w.z = cvt_pk_bf16(v1[0], v1[1]); w.w = cvt_pk_bf16(v1[2], v1[3]);
                    *(u32x4*)(rowp + bj * HALF) = w;
                    if (m == 3 && hal && fr >= 13) *(u32x4*)(halo + (size_t)((r >> 6) * 3 + (fr - 13)) * ld1 + col0 + bj * HALF) = w; } }
    }
};
struct EpiSwiGLU {
    static constexpr bool PERM = false, AFTER_DRAIN = false;
    bf16_t* H; int ldh;
    __device__ __forceinline__ void operator()(const f32x4 (&acc)[2][2][4][2], const Unit& u, int wr, int wc, int fr, int fq) const {
        const int row0 = u.pm * BM + wr * 64 + fr; const int hcol0 = (u.pn * BM + wc * 32) / 2 + 4 * fq;
        typedef unsigned u32x2v __attribute__((ext_vector_type(2)));
#pragma unroll
        for (int ai = 0; ai < 2; ++ai)
#pragma unroll
            for (int m = 0; m < 4; ++m) { bf16_t* rowp = H + (size_t)(row0 + ai * HALF + m * 16) * ldh + hcol0;
#pragma unroll
                for (int bj = 0; bj < 2; ++bj) { const f32x4 g = acc[ai][bj][m][0], up = acc[ai][bj][m][1];
                    u32x2v w; w.x = cvt_pk_bf16(silu_f(g[0]) * up[0], silu_f(g[1]) * up[1]); w.y = cvt_pk_bf16(silu_f(g[2]) * up[2], silu_f(g[3]) * up[3]);
                    *(u32x2v*)(rowp + bj * 64) = w; } }
    }
};
template <class Epi, class Sched, bool ALIGN_EPI = false, bool SP2 = false>
__device__ __forceinline__ void gemm_phase(PG8_LAS unsigned char* lds, const Gemm g, const Sched& S, const Epi& E) {
    const int tid = threadIdx.x, wid = __builtin_amdgcn_readfirstlane(tid >> 6), lane = tid & 63, wr = wid >> 2, wc = wid & 3, fr = lane & 15, fq = lane >> 4;
    const int K = g.K, nt = K / BK;
    unsigned voffA[2], voffB[2];
#pragma unroll
    for (int i = 0; i < 2; ++i) { int R, C; stage_rc(tid * 16 + i * 8192, R, C); const int Rb = Epi::PERM ? ((R & ~31) + perm32(R & 31)) : R;
        voffA[i] = (unsigned)(R * K + C) * 2u; voffB[i] = (unsigned)(Rb * K + C) * 2u; }
    const size_t kstep = (size_t)(BK * 2);
    const size_t hstep = (size_t)HALF * K * 2;
    const size_t tstep = 2 * hstep;
    const unsigned ldsw = (unsigned)wid * 1024u;
    const int aoff = lds_byte(wr * 64 + fr, fq * 8), boff = lds_byte(wc * 32 + fr, fq * 8);
#define PG8_SA(b, h) (((b) * 2 + (h)) * HTB)
#define PG8_SB(b, h) ((4 + (b) * 2 + (h)) * HTB)
#define PG8_STAGE(bufoff, gbase, voff) do { _Pragma("unroll") for (int _i = 0; _i < 2; ++_i) \
        __builtin_amdgcn_global_load_lds((const unsigned*)((const char*)(gbase) + (voff)[_i]), (PG8_LAS unsigned*)(lds + (bufoff) + ldsw + _i * 8192), 16, 0, 0); } while (0)
#define PG8_LDA(dst, b, h) do { _Pragma("unroll") for (int m = 0; m < 4; ++m) _Pragma("unroll") for (int k = 0; k < 2; ++k) dst[m][k] = *(const PG8_LAS bf16x8*)(lds + PG8_SA(b, h) + aoff + m * 2048 + k * 1024); } while (0)
#define PG8_LDB(dst, b, h) do { _Pragma("unroll") for (int n = 0; n < 2; ++n) _Pragma("unroll") for (int k = 0; k < 2; ++k) dst[n][k] = *(const PG8_LAS bf16x8*)(lds + PG8_SB(b, h) + boff + n * 2048 + k * 1024); } while (0)
#define PG8_MMA(ai, bj, At, Bt) do { __builtin_amdgcn_s_setprio(1); _Pragma("unroll") for (int m = 0; m < 4; ++m) _Pragma("unroll") for (int n = 0; n < 2; ++n) _Pragma("unroll") for (int k = 0; k < 2; ++k) \
        acc[ai][bj][m][n] = __builtin_amdgcn_mfma_f32_16x16x32_bf16(Bt[n][k], At[m][k], acc[ai][bj][m][n], 0, 0, 0); __builtin_amdgcn_s_setprio(0); } while (0)
#define PG8_WAIT_V(n) asm volatile("s_waitcnt vmcnt(" #n ")" ::: "memory")
#define PG8_WAIT_L(n) asm volatile("s_waitcnt lgkmcnt(" #n ")" ::: "memory")
#define PG8_BAR __builtin_amdgcn_s_barrier()
#define PG8_SCHED __builtin_amdgcn_sched_barrier(0)
    Unit cur, nxt; int ui = 0;
    if (!S.next(0, cur)) return;
    f32x4 acc[2][2][4][2];
#pragma unroll
    for (int a = 0; a < 2; ++a)
#pragma unroll
        for (int b = 0; b < 2; ++b)
#pragma unroll
            for (int m = 0; m < 4; ++m)
#pragma unroll
                for (int n = 0; n < 2; ++n) acc[a][b][m][n] = (f32x4){0.f, 0.f, 0.f, 0.f};
    bf16x8 At[4][2], B0[2][2], B1[2][2];
    const char* cA = (const char*)g.A + (size_t)cur.pm * tstep; const char* cB = (const char*)g.Bt + (size_t)cur.pn * tstep;
    S.a_ready(cur);
    if constexpr (SP2) {
        PG8_STAGE(PG8_SB(0, 0), cB, voffB); PG8_STAGE(PG8_SB(0, 1), cB + hstep, voffB); PG8_STAGE(PG8_SA(0, 0), cA, voffA); PG8_STAGE(PG8_SA(0, 1), cA + hstep, voffA);
        if (wr == 1) PG8_BAR;
        PG8_WAIT_V(2); PG8_BAR;
        PG8_STAGE(PG8_SB(1, 0), cB + kstep, voffB); PG8_STAGE(PG8_SA(1, 0), cA + kstep, voffA); PG8_STAGE(PG8_SB(1, 1), cB + hstep + kstep, voffB);
        PG8_WAIT_V(6); PG8_BAR;
    } else {
        PG8_STAGE(PG8_SB(0, 0), cB, voffB); PG8_STAGE(PG8_SA(0, 0), cA, voffA); PG8_STAGE(PG8_SB(0, 1), cB + hstep, voffB); PG8_STAGE(PG8_SA(0, 1), cA + hstep, voffA);
        if (wr == 1) PG8_BAR;
        PG8_WAIT_V(4); PG8_BAR;
        PG8_STAGE(PG8_SB(1, 0), cB + kstep, voffB); PG8_STAGE(PG8_SA(1, 0), cA + kstep, voffA); PG8_STAGE(PG8_SB(1, 1), cB + hstep + kstep, voffB);
        PG8_WAIT_V(6); PG8_BAR;
    }
    for (;;) {
        const bool has_next = S.next(ui + 1, nxt);
        const char* nA = has_next ? (const char*)g.A + (size_t)nxt.pm * tstep : cA; const char* nB = has_next ? (const char*)g.Bt + (size_t)nxt.pn * tstep : cB;
        for (int t = 0; t < nt; t += 2) {
            const bool last = (t == nt - 2);
            const char* a1 = cA + (size_t)(t + 1) * kstep;
            const char* a2 = last ? nA : cA + (size_t)(t + 2) * kstep; const char* b2 = last ? nB : cB + (size_t)(t + 2) * kstep;
            const char* a3 = a2 + kstep; const char* b3 = b2 + kstep;
            if (last && has_next) S.a_ready(nxt);
            if constexpr (SP2) {
            PG8_LDB(B0, 0, 0); PG8_LDB(B1, 0, 1); PG8_SCHED; PG8_LDA(At, 0, 0); PG8_STAGE(PG8_SA(1, 1), a1 + hstep, voffA);
            PG8_WAIT_V(8); PG8_WAIT_L(0); PG8_BAR; PG8_MMA(0, 0, At, B0); PG8_MMA(0, 1, At, B1); PG8_BAR; PG8_SCHED;
            PG8_LDA(At, 0, 1); PG8_STAGE(PG8_SB(0, 0), b2, voffB); PG8_STAGE(PG8_SB(0, 1), b2 + hstep, voffB); PG8_STAGE(PG8_SA(0, 0), a2, voffA);
            PG8_WAIT_V(8); PG8_WAIT_L(0); PG8_BAR; PG8_MMA(1, 0, At, B0); PG8_MMA(1, 1, At, B1); PG8_BAR; PG8_SCHED;
            PG8_LDB(B0, 1, 0); PG8_LDB(B1, 1, 1); PG8_SCHED; PG8_LDA(At, 1, 0); PG8_STAGE(PG8_SA(0, 1), a2 + hstep, voffA);
            PG8_WAIT_V(8); PG8_WAIT_L(0); PG8_BAR; PG8_MMA(0, 0, At, B0); PG8_MMA(0, 1, At, B1); PG8_BAR; PG8_SCHED;
            PG8_LDA(At, 1, 1); PG8_STAGE(PG8_SB(1, 0), b3, voffB); PG8_STAGE(PG8_SB(1, 1), b3 + hstep, voffB); PG8_STAGE(PG8_SA(1, 0), a3, voffA);
            PG8_WAIT_V(8); PG8_WAIT_L(0); PG8_BAR; PG8_MMA(1, 0, At, B0); PG8_MMA(1, 1, At, B1); PG8_BAR; PG8_SCHED;
            } else {
            PG8_LDB(B0, 0, 0); PG8_SCHED; PG8_LDA(At, 0, 0); PG8_STAGE(PG8_SA(1, 1), a1 + hstep, voffA);
            PG8_WAIT_L(8); PG8_BAR; PG8_WAIT_L(0); PG8_MMA(0, 0, At, B0); PG8_BAR; PG8_SCHED;
            PG8_LDB(B1, 0, 1); PG8_STAGE(PG8_SB(0, 0), b2, voffB);
            PG8_BAR; PG8_WAIT_L(0); PG8_MMA(0, 1, At, B1); PG8_BAR;
            PG8_LDA(At, 0, 1); PG8_STAGE(PG8_SA(0, 0), a2, voffA);
            PG8_BAR; PG8_WAIT_L(0); PG8_MMA(1, 0, At, B0); PG8_BAR; PG8_SCHED;
            PG8_STAGE(PG8_SB(0, 1), b2 + hstep, voffB);
            PG8_WAIT_V(6); PG8_BAR; PG8_MMA(1, 1, At, B1); PG8_BAR;
            PG8_LDB(B0, 1, 0); PG8_SCHED; PG8_LDA(At, 1, 0); PG8_STAGE(PG8_SA(0, 1), a2 + hstep, voffA);
            PG8_WAIT_L(8); PG8_BAR; PG8_WAIT_L(0); PG8_MMA(0, 0, At, B0); PG8_BAR; PG8_SCHED;
            PG8_LDB(B1, 1, 1); PG8_STAGE(PG8_SB(1, 0), b3, voffB);
            PG8_BAR; PG8_WAIT_L(0); PG8_MMA(0, 1, At, B1); PG8_BAR;
            PG8_LDA(At, 1, 1); PG8_STAGE(PG8_SA(1, 0), a3, voffA);
            PG8_BAR; PG8_WAIT_L(0); PG8_MMA(1, 0, At, B0); PG8_BAR; PG8_SCHED;
            PG8_STAGE(PG8_SB(1, 1), b3 + hstep, voffB);
            PG8_WAIT_V(6); PG8_BAR; PG8_MMA(1, 1, At, B1); PG8_BAR;
            }
        }
        if constexpr (ALIGN_EPI) { if (wr == 0) PG8_BAR; }
        if constexpr (!Epi::AFTER_DRAIN) { E(acc, cur, wr, wc, fr, fq); S.done(cur); }
        if (!has_next) break;
#pragma unroll
        for (int a = 0; a < 2; ++a)
#pragma unroll
            for (int b = 0; b < 2; ++b)
#pragma unroll
                for (int m = 0; m < 4; ++m)
#pragma unroll
                    for (int n = 0; n < 2; ++n) acc[a][b][m][n] = (f32x4){0.f, 0.f, 0.f, 0.f};
        cur = nxt; cA = nA; cB = nB; ++ui;
        if constexpr (ALIGN_EPI) { if (wr == 1) PG8_BAR; }
    }
    PG8_WAIT_V(0);
    if constexpr (!ALIGN_EPI) { if (wr == 0) PG8_BAR; }
    PG8_BAR;
    if constexpr (Epi::AFTER_DRAIN) { E.fused(acc, cur, wr, wc, fr, fq, lds, wid, lane); S.done(cur); }
#undef PG8_SA
#undef PG8_SB
#undef PG8_STAGE
#undef PG8_LDA
#undef PG8_LDB
#undef PG8_MMA
#undef PG8_WAIT_V
#undef PG8_WAIT_L
#undef PG8_BAR
#undef PG8_SCHED
}
}

#define LAS __attribute__((address_space(3)))
typedef unsigned short bf16;
typedef pg8::f32x4 f32x4;
typedef pg8::bf16x8 bf16x8;
typedef pg8::u32x4 u32x4;
typedef unsigned u32x2 __attribute__((ext_vector_type(2)));
typedef float f32x2 __attribute__((ext_vector_type(2)));

constexpr int NWAVES = 8, NTHR = 512;
constexpr int DM = 1024, MPR = 16384, MV = 16512, MPAD = 16640, SEQ = 8192;
constexpr int AB_IN = 2304, DFF = 2816, SSM_INP = 5376, SSM_INV = 5152, XBCW = 3072, ZW = 2048;
constexpr float EPS = 1e-6f;
constexpr size_t MiB = 1u << 20;
constexpr size_t WS_ROPE = 0, WS_BAR = 512 * 1024, BAR_BYTES = 16384;
constexpr size_t WS_W_ABIN = 1 * MiB, WS_W_ABOUT = WS_W_ABIN + 9 * MiB / 2, WS_W_UP0 = WS_W_ABOUT + 2 * MiB, WS_W_DN0 = WS_W_UP0 + 11 * MiB;
constexpr size_t WS_HALO = 1 * MiB, WS_DT = 6 * MiB, WS_SEG = 9 * MiB, WS_SEGD = 16 * MiB;
constexpr size_t WS_W_SSMIN = 24 * MiB, WS_W_SSMOUT = WS_W_SSMIN + 21 * MiB / 2, WS_W_UP1 = WS_W_SSMOUT + 4 * MiB, WS_W_DN1 = WS_W_UP1 + 11 * MiB;
constexpr size_t WS_XN = 55 * MiB;
constexpr size_t WS_P0 = 88 * MiB, WS_CAT = 162 * MiB, WS_MIX = 195 * MiB, WS_H = 88 * MiB, WS_Z = 88 * MiB, WS_XBC = 153 * MiB, WS_END = 256 * MiB;
static_assert(WS_W_DN0 + (size_t)DM * DFF * 2 <= 24 * MiB && WS_W_DN1 + (size_t)DM * DFF * 2 <= WS_XN && WS_XN + (size_t)MPAD * DM * 2 <= WS_P0, "ws map 1");
static_assert(WS_P0 + (size_t)MPAD * AB_IN * 2 <= WS_CAT && WS_CAT + (size_t)MPAD * DM * 2 <= WS_MIX && WS_MIX + (size_t)MPAD * DM * 2 <= WS_END, "ws map 2");
static_assert(WS_H + (size_t)MPAD * DFF * 2 <= WS_MIX && WS_Z + (size_t)MPAD * ZW * 2 <= WS_XBC && WS_XBC + (size_t)MPAD * XBCW * 2 <= WS_END, "ws map 3");
static_assert(WS_HALO + (size_t)260 * 3 * XBCW * 2 <= WS_DT && WS_DT + (size_t)MPAD * 32 * 4 <= WS_SEG && WS_SEG + (size_t)192 * 8192 * 4 <= WS_SEGD, "ws map 4");
constexpr size_t O_Y = 0, O_KP = 16908288, O_VP = O_KP + 32768, O_SCP = O_VP + 32768, O_CCP = O_SCP + 2048, O_SSP = O_CCP + 18432, O_KS = O_SSP + 524288, O_VS = O_KS + 16384,
                 O_SCS = O_VS + 16384, O_CCS = O_SCS + 8192, O_SSS = O_CCS + 73728, O_END = O_SSS + 2097152;
static_assert(O_END == 19730432, "output size");
constexpr int LDS_BYTES = 147456;

struct Args { const float* in[23]; float* out; unsigned char* ws; int ph_lo, ph_hi; };
enum { I_XP = 0, I_XS, I_CK, I_CV, I_SCONV, I_SSMCONV, I_SSM, I_NG, I_ABIN, I_ABOUT, I_SINK, I_SCW, I_SSMIN, I_SSMCW, I_SSMCB, I_DTB, I_ALOG, I_SSMD, I_SSMNG, I_SSMOUT, I_FG, I_FU, I_FD };

#define LDS_WAIT() asm volatile("s_waitcnt lgkmcnt(0)" ::: "memory")
typedef __bf16 bf16x2_t __attribute__((ext_vector_type(2)));
__device__ __forceinline__ unsigned pk2(float lo, float hi) { const f32x2 v = {lo, hi}; const bf16x2_t b = __builtin_convertvector(v, bf16x2_t); return __builtin_bit_cast(unsigned, b); }
__device__ __forceinline__ unsigned short f2bf(float f) { return (unsigned short)(pk2(f, 0.f) & 0xffffu); }
__device__ __forceinline__ float bflo(unsigned w) { return __builtin_bit_cast(float, w << 16); }
__device__ __forceinline__ float bfhi(unsigned w) { return __builtin_bit_cast(float, w & 0xffff0000u); }
__device__ __forceinline__ float bf1(unsigned short h) { return __builtin_bit_cast(float, (unsigned)h << 16); }
__device__ __forceinline__ void unpack8(const u32x4 w, float (&f)[8]) { f[0] = bflo(w.x); f[1] = bfhi(w.x); f[2] = bflo(w.y); f[3] = bfhi(w.y); f[4] = bflo(w.z); f[5] = bfhi(w.z); f[6] = bflo(w.w); f[7] = bfhi(w.w); }
__device__ __forceinline__ u32x4 pack8(const float (&f)[8]) { u32x4 w; w.x = pk2(f[0], f[1]); w.y = pk2(f[2], f[3]); w.z = pk2(f[4], f[5]); w.w = pk2(f[6], f[7]); return w; }
__device__ __forceinline__ float wave_sum(float v) {
#pragma unroll
    for (int o = 1; o < 64; o <<= 1) v += __shfl_xor(v, o);
    return v;
}
__device__ __forceinline__ float silu(float v) { return v * __builtin_amdgcn_rcpf(1.0f + __expf(-v)); }
__device__ __forceinline__ f32x4 mfma16(bf16x8 a, bf16x8 b, f32x4 c) { return __builtin_amdgcn_mfma_f32_16x16x32_bf16(a, b, c, 0, 0, 0); }

__device__ __forceinline__ void transpose_item(const float* W, int K, int N, bf16* WT, int mode, LAS float* scr, int item, int lane) {
    const int nblk = N / 32, kb = item / nblk, nb = item % nblk, k0 = 64 * kb, n0 = 32 * nb;
    float wv_[32];
#pragma unroll
    for (int i = 0; i < 32; ++i) wv_[i] = W[(size_t)(k0 + 2 * i + (lane >> 5)) * N + n0 + (lane & 31)];
#pragma unroll
    for (int i = 0; i < 32; ++i) scr[(2 * i + (lane >> 5)) * 33 + (lane & 31)] = wv_[i];
    LDS_WAIT(); asm volatile("" ::: "memory");
    const int c = lane & 7;
#pragma unroll
    for (int j = 0; j < 4; ++j) { const int n = (lane >> 3) + 8 * j; const LAS float* s = scr + (8 * c) * 33 + n; const int cn = n0 + n;
        const int drow = (mode == 0) ? cn : (((cn >> 4) << 5) + (cn & 15) + (mode == 2 ? 16 : 0));
        u32x4 o; o.x = pk2(s[0 * 33], s[1 * 33]); o.y = pk2(s[2 * 33], s[3 * 33]); o.z = pk2(s[4 * 33], s[5 * 33]); o.w = pk2(s[6 * 33], s[7 * 33]);
        *(u32x4*)(WT + (size_t)drow * K + k0 + 8 * c) = o; }
    LDS_WAIT(); asm volatile("" ::: "memory");
}
__device__ __forceinline__ void p0_prologue(const Args& a, LAS unsigned char* lds, int G, int bid) {
    const int tid = threadIdx.x, lane = tid & 63, wave = tid >> 6;
    unsigned char* ws = a.ws;
    LAS float* scr = (LAS float*)(lds + wave * 16384);
    const int gw = bid * NWAVES + wave, NGW = G * NWAVES;
    constexpr int I_1 = 16 * 72, I_2 = 16 * 32, I_F = 16 * 88, I_D = 44 * 32, I_5 = 16 * 161, I_6 = 32 * 32;
    constexpr int NITEMS = I_1 + I_2 + 4 * I_F + 2 * I_D + I_5 + I_6;
    for (int it = gw; it < NITEMS; it += NGW) {
        int r = it;
        if (r < I_5) { transpose_item(a.in[I_SSMIN], DM, SSM_INV, (bf16*)(ws + WS_W_SSMIN), 0, scr, r, lane); continue; } r -= I_5;
        if (r < I_1) { transpose_item(a.in[I_ABIN], DM, AB_IN, (bf16*)(ws + WS_W_ABIN), 0, scr, r, lane); continue; } r -= I_1;
        if (r < I_2) { transpose_item(a.in[I_ABOUT], DM, DM, (bf16*)(ws + WS_W_ABOUT), 0, scr, r, lane); continue; } r -= I_2;
        if (r < I_F) { transpose_item(a.in[I_FG], DM, DFF, (bf16*)(ws + WS_W_UP0), 1, scr, r, lane); continue; } r -= I_F;
        if (r < I_F) { transpose_item(a.in[I_FU], DM, DFF, (bf16*)(ws + WS_W_UP0), 2, scr, r, lane); continue; } r -= I_F;
        if (r < I_D) { transpose_item(a.in[I_FD], DFF, DM, (bf16*)(ws + WS_W_DN0), 0, scr, r, lane); continue; } r -= I_D;
        if (r < I_6) { transpose_item(a.in[I_SSMOUT], ZW, DM, (bf16*)(ws + WS_W_SSMOUT), 0, scr, r, lane); continue; } r -= I_6;
        if (r < I_F) { transpose_item(a.in[I_FG] + (size_t)DM * DFF, DM, DFF, (bf16*)(ws + WS_W_UP1), 1, scr, r, lane); continue; } r -= I_F;
        if (r < I_F) { transpose_item(a.in[I_FU] + (size_t)DM * DFF, DM, DFF, (bf16*)(ws + WS_W_UP1), 2, scr, r, lane); continue; } r -= I_F;
        transpose_item(a.in[I_FD] + (size_t)DM * DFF, DFF, DM, (bf16*)(ws + WS_W_DN1), 0, scr, r, lane);
    }
    const int gt = bid * NTHR + tid, NGT = G * NTHR;
    { u32x4 z = (u32x4){0u, 0u, 0u, 0u};
      u32x4* p1 = (u32x4*)((bf16*)(ws + WS_W_SSMIN) + (size_t)SSM_INV * DM); for (int i = gt; i < (SSM_INP - SSM_INV) * DM / 8; i += NGT) p1[i] = z;
      u32x4* p2 = (u32x4*)((bf16*)(ws + WS_XN) + (size_t)MV * DM); for (int i = gt; i < (MPAD - MV) * DM / 8; i += NGT) p2[i] = z; }
    { f32x2* rope = (f32x2*)(ws + WS_ROPE);
      for (int i = gt; i < SEQ * 8; i += NGT) { const int pos = i >> 3, k = i & 7;
          const double invf = k == 0 ? 1.0 : k == 1 ? 0.19392274474868576 : k == 2 ? 0.03760603093086393 : k == 3 ? 0.007292664737217109 : k == 4 ? 0.001414213562373095 : k == 5 ? 0.0002742481756762073 : k == 6 ? 5.318295896944988e-05 : 1.031338537721246e-05;
          const double rev = (double)pos * invf * 0.15915494309189535; const float fr = (float)(rev - __builtin_floor(rev));
          rope[i] = (f32x2){__builtin_amdgcn_cosf(fr), __builtin_amdgcn_sinf(fr)}; } }
    const f32x4* g4 = (const f32x4*)(a.in[I_NG]);
    for (int row = gw; row < MV; row += NGW) {
        const f32x4* src = (const f32x4*)(row < MPR ? a.in[I_XP] + (size_t)row * DM : a.in[I_XS] + (size_t)(row - MPR) * DM);
        f32x4 v[4]; float ss = 0.f;
#pragma unroll
        for (int j = 0; j < 4; ++j) { v[j] = src[lane + 64 * j]; ss += (v[j].x * v[j].x + v[j].y * v[j].y) + (v[j].z * v[j].z + v[j].w * v[j].w); }
        const float r = __builtin_amdgcn_rsqf(wave_sum(ss) * (1.f / DM) + EPS);
        u32x2* o = (u32x2*)((bf16*)(ws + WS_XN) + (size_t)row * DM);
#pragma unroll
        for (int j = 0; j < 4; ++j) { const f32x4 g = g4[lane + 64 * j]; u32x2 w; w.x = pk2(v[j].x * r * g.x, v[j].y * r * g.y); w.y = pk2(v[j].z * r * g.z, v[j].w * r * g.w); o[lane + 64 * j] = w; }
    }
}
constexpr size_t XR_BYTE_OFF = (size_t)MV * DM * 2;
template <bool FIRST>
__device__ __forceinline__ void nrn_mid(const Args& a, const float* g1, const float* g2, int G, int bid) {
    const int tid = threadIdx.x, lane = tid & 63, wave = tid >> 6;
    const int gw = bid * NWAVES + wave, NGW = G * NWAVES;
    const bf16* mix = (const bf16*)(a.ws + WS_MIX); bf16* xn = (bf16*)(a.ws + WS_XN); bf16* xr = (bf16*)((unsigned char*)a.out + XR_BYTE_OFF);
    const f32x4* g14 = (const f32x4*)g1; const f32x4* g24 = (const f32x4*)g2;
    for (int row = gw; row < MV; row += NGW) {
        const u32x2* mp = (const u32x2*)(mix + (size_t)row * DM);
        u32x2* xrp = (u32x2*)(xr + (size_t)row * DM);
        const f32x4* xs = (const f32x4*)(row < MPR ? a.in[I_XP] + (size_t)row * DM : a.in[I_XS] + (size_t)(row - MPR) * DM);
        f32x4 m[4], xv[4]; float ss = 0.f;
#pragma unroll
        for (int j = 0; j < 4; ++j) { const u32x2 w = mp[lane + 64 * j]; m[j] = (f32x4){bflo(w.x), bfhi(w.x), bflo(w.y), bfhi(w.y)};
            if (FIRST) xv[j] = xs[lane + 64 * j]; else { const u32x2 xw = xrp[lane + 64 * j]; xv[j] = (f32x4){bflo(xw.x), bfhi(xw.x), bflo(xw.y), bfhi(xw.y)}; }
            ss += (m[j].x * m[j].x + m[j].y * m[j].y) + (m[j].z * m[j].z + m[j].w * m[j].w); }
        const float r1 = __builtin_amdgcn_rsqf(wave_sum(ss) * (1.f / DM) + EPS);
        float s2 = 0.f;
#pragma unroll
        for (int j = 0; j < 4; ++j) { const f32x4 g = g14[lane + 64 * j]; xv[j] = xv[j] + m[j] * r1 * g; u32x2 w; w.x = pk2(xv[j].x, xv[j].y); w.y = pk2(xv[j].z, xv[j].w); xrp[lane + 64 * j] = w;
            s2 += (xv[j].x * xv[j].x + xv[j].y * xv[j].y) + (xv[j].z * xv[j].z + xv[j].w * xv[j].w); }
        const float r2 = __builtin_amdgcn_rsqf(wave_sum(s2) * (1.f / DM) + EPS);
        u32x2* o = (u32x2*)(xn + (size_t)row * DM);
#pragma unroll
        for (int j = 0; j < 4; ++j) { const f32x4 g = g24[lane + 64 * j]; u32x2 w; w.x = pk2(xv[j].x * r2 * g.x, xv[j].y * r2 * g.y); w.y = pk2(xv[j].z * r2 * g.z, xv[j].w * r2 * g.w); o[lane + 64 * j] = w; }
    }
}
typedef short v4i16_t __attribute__((ext_vector_type(4)));
__device__ __forceinline__ u32x2 trd(const LAS bf16* X, int ST, int r0, int c0, int lane) {
    const int q = (lane & 15) >> 2, p = lane & 3;
    return __builtin_bit_cast(u32x2, __builtin_amdgcn_ds_read_tr16_b64_v4i16((LAS v4i16_t*)(X + (r0 + q) * ST + c0 + 4 * p)));
}
__device__ __forceinline__ bf16x8 trfrag(const LAS bf16* X, int ST, int kb, int c0, int lane) {
    const int fq = lane >> 4; const u32x2 lo = trd(X, ST, kb + 8 * fq, c0, lane), hi = trd(X, ST, kb + 8 * fq + 4, c0, lane);
    const u32x4 t = (u32x4){lo.x, lo.y, hi.x, hi.y}; return __builtin_bit_cast(bf16x8, t);
}
__device__ __forceinline__ void load8_rope(const bf16* hp, int dg, const f32x2* rp, float (&o)[8]) {
    const u32x4 w = *(const u32x4*)(hp + dg * 8); unpack8(w, o);
    if (dg < 2) { float p[8]; const u32x4 w2 = *(const u32x4*)(hp + (1 - dg) * 8); unpack8(w2, p);
#pragma unroll
        for (int j = 0; j < 8; ++j) { const f32x2 cs = rp[j]; o[j] = dg == 0 ? o[j] * cs.x - p[j] * cs.y : o[j] * cs.x + p[j] * cs.y; } }
}
__device__ __forceinline__ void attn_phase(const Args& a, LAS unsigned char* lds, int G, int bid) {
    LAS bf16* Qs = (LAS bf16*)lds;
    LAS bf16* Ks = (LAS bf16*)(lds + 36864);
    LAS bf16* Vs = (LAS bf16*)(lds + 64512);
    const int tid = threadIdx.x, lane = tid & 63, w = tid >> 6, fr = lane & 15, fq = lane >> 4;
    const bf16* P0 = (const bf16*)(a.ws + WS_P0); bf16* CAT = (bf16*)(a.ws + WS_CAT);
    const f32x2* rope = (const f32x2*)(a.ws + WS_ROPE);
    for (int u = bid; u < 528; u += G) {
        const bool smp = u >= 512;
        int b, c = 0, kvh, nq, nkc = 0, nvalid, qrow0;
        if (!smp) { kvh = u & 1; c = (u >> 1) & 127; b = u >> 8; nq = 64; nkc = (c < 2 ? c : 2) + 1; nvalid = 64 * nkc; qrow0 = b * SEQ + c * 64; }
        else { const int v = u - 512; kvh = v & 1; b = v >> 1; nq = 16; nvalid = 144; qrow0 = MPR + b * 16; }
#pragma unroll
        for (int it = 0; it < 4; ++it) { const int item = tid + NTHR * it, q = item >> 3, dg = item & 7, hh = q >> 6, i = q & 63;
            u32x4 o = (u32x4){0u, 0u, 0u, 0u};
            if (i < nq) { const int pos = smp ? 4096 + i : c * 64 + i; float f[8]; load8_rope(P0 + (size_t)(qrow0 + i) * AB_IN + (4 * kvh + hh) * 64, dg, rope + pos * 8, f);
#pragma unroll
                for (int j = 0; j < 8; ++j) f[j] *= 0.125f;
                o = pack8(f); }
            *(LAS u32x4*)(Qs + q * 72 + dg * 8) = o; }
#pragma unroll
        for (int it = 0; it < 3; ++it) { const int item = tid + NTHR * it, kr = item >> 3, dg = item & 7;
            u32x4 ko = (u32x4){0u, 0u, 0u, 0u}, vo = ko;
            if (kr < nvalid) {
                if (smp && kr < 128) { const size_t off = ((size_t)(b * 128 + kr) * 2 + kvh) * 64 + dg * 8;
                    const f32x4 k0 = *(const f32x4*)(a.in[I_CK] + off), k1 = *(const f32x4*)(a.in[I_CK] + off + 4), v0 = *(const f32x4*)(a.in[I_CV] + off), v1 = *(const f32x4*)(a.in[I_CV] + off + 4);
                    ko.x = pk2(k0.x, k0.y); ko.y = pk2(k0.z, k0.w); ko.z = pk2(k1.x, k1.y); ko.w = pk2(k1.z, k1.w); vo.x = pk2(v0.x, v0.y); vo.y = pk2(v0.z, v0.w); vo.z = pk2(v1.x, v1.y); vo.w = pk2(v1.z, v1.w); }
                else { int row, pos; if (smp) { row = MPR + b * 16 + (kr - 128); pos = 4096 + kr - 128; } else { pos = (c - nkc + 1 + (kr >> 6)) * 64 + (kr & 63); row = b * SEQ + pos; }
                    const bf16* rp = P0 + (size_t)row * AB_IN; float f[8]; load8_rope(rp + 512 + kvh * 64, dg, rope + pos * 8, f); ko = pack8(f);
                    vo = *(const u32x4*)(rp + 640 + kvh * 64 + dg * 8); }
            }
            *(LAS u32x4*)(Ks + kr * 72 + dg * 8) = ko;
            *(LAS u32x4*)(Vs + kr * 72 + dg * 8) = vo; }
        __syncthreads();
        const int hh = w >> 1, qh = w & 1;
        if (qh * 32 < nq) {
            f32x4 s[12][2];
#pragma unroll
            for (int kt = 0; kt < 12; ++kt) { s[kt][0] = (f32x4){0.f, 0.f, 0.f, 0.f}; s[kt][1] = s[kt][0]; }
#pragma unroll
            for (int ks = 0; ks < 2; ++ks) {
                bf16x8 bq[2];
#pragma unroll
                for (int qt = 0; qt < 2; ++qt) bq[qt] = *(const LAS bf16x8*)(Qs + (w * 32 + qt * 16 + fr) * 72 + ks * 32 + fq * 8);
#pragma unroll
                for (int kt = 0; kt < 12; ++kt) if (kt * 16 < nvalid) { const bf16x8 ak = *(const LAS bf16x8*)(Ks + (kt * 16 + fr) * 72 + ks * 32 + fq * 8);
                    s[kt][0] = mfma16(ak, bq[0], s[kt][0]); s[kt][1] = mfma16(ak, bq[1], s[kt][1]); }
            }
            const float sink = a.in[I_SINK][4 * kvh + hh];
            float inv[2];
#pragma unroll
            for (int qt = 0; qt < 2; ++qt) {
                float m = sink;
#pragma unroll
                for (int kt = 0; kt < 12; ++kt) if (kt * 16 < nvalid) m = fmaxf(fmaxf(m, fmaxf(s[kt][qt][0], s[kt][qt][1])), fmaxf(s[kt][qt][2], s[kt][qt][3]));
                m = fmaxf(m, __shfl_xor(m, 16)); m = fmaxf(m, __shfl_xor(m, 32));
                float sum = 0.f;
#pragma unroll
                for (int kt = 0; kt < 12; ++kt) { if (kt * 16 < nvalid) {
#pragma unroll
                        for (int i = 0; i < 4; ++i) { const float p = __expf(s[kt][qt][i] - m); s[kt][qt][i] = p; sum += p; } }
                    else s[kt][qt] = (f32x4){0.f, 0.f, 0.f, 0.f}; }
                sum += __shfl_xor(sum, 16); sum += __shfl_xor(sum, 32);
                inv[qt] = 1.0f / (sum + __expf(sink - m));
            }
            f32x4 o[4][2];
#pragma unroll
            for (int dt = 0; dt < 4; ++dt) { o[dt][0] = (f32x4){0.f, 0.f, 0.f, 0.f}; o[dt][1] = o[dt][0]; }
#pragma unroll
            for (int kk = 0; kk < 6; ++kk) if (kk * 32 < nvalid) {
                bf16x8 bp[2];
#pragma unroll
                for (int qt = 0; qt < 2; ++qt) { u32x4 t; t.x = pk2(s[2 * kk][qt][0], s[2 * kk][qt][1]); t.y = pk2(s[2 * kk][qt][2], s[2 * kk][qt][3]); t.z = pk2(s[2 * kk + 1][qt][0], s[2 * kk + 1][qt][1]); t.w = pk2(s[2 * kk + 1][qt][2], s[2 * kk + 1][qt][3]);
                    bp[qt] = __builtin_bit_cast(bf16x8, t); }
#pragma unroll
                for (int dt = 0; dt < 4; ++dt) { const u32x2 lo = trd(Vs, 72, kk * 32 + 4 * fq, dt * 16, lane), hi = trd(Vs, 72, kk * 32 + 16 + 4 * fq, dt * 16, lane);
                    const u32x4 t = (u32x4){lo.x, lo.y, hi.x, hi.y}; const bf16x8 av = __builtin_bit_cast(bf16x8, t);
                    o[dt][0] = mfma16(av, bp[0], o[dt][0]); o[dt][1] = mfma16(av, bp[1], o[dt][1]); }
            }
#pragma unroll
            for (int qt = 0; qt < 2; ++qt) { const int tok = qh * 32 + qt * 16 + fr;
                if (tok < nq) { bf16* op = CAT + (size_t)(qrow0 + tok) * DM + (4 * kvh + hh) * 64 + 4 * fq;
#pragma unroll
                    for (int dt = 0; dt < 4; ++dt) { const f32x4 v = o[dt][qt] * inv[qt]; u32x2 wv; wv.x = pk2(v[0], v[1]); wv.y = pk2(v[2], v[3]); *(u32x2*)(op + dt * 16) = wv; } } }
        }
        __syncthreads();
    }
    const int gt = bid * NTHR + tid, NGT = G * NTHR;
    const float* scw = a.in[I_SCW];
    for (int it = gt; it < MV * 64; it += NGT) { const int row = it >> 6, ch = (it & 63) * 8;
        int t, L, bb; if (row < MPR) { bb = row >> 13; t = row & (SEQ - 1); L = SEQ; } else { bb = (row - MPR) >> 4; t = (row - MPR) & 15; L = 16; }
        float acc[8], uc[8];
#pragma unroll
        for (int j = 0; j < 8; ++j) acc[j] = 0.f;
#pragma unroll
        for (int d = 0; d < 3; ++d) {
            const int tt = t - 2 + d; float uu[8];
            if (tt >= 0) { const bf16* rp = P0 + (size_t)(row - 2 + d) * AB_IN; float gc[8], hx[8]; unpack8(*(const u32x4*)(rp + 1280 + ch), gc); unpack8(*(const u32x4*)(rp + 1792 + ch), hx);
#pragma unroll
                for (int j = 0; j < 8; ++j) uu[j] = gc[j] * hx[j]; }
            else if (row >= MPR) { const float* hp = a.in[I_SCONV] + ((size_t)bb * 2 + (2 + tt)) * 512 + ch;
#pragma unroll
                for (int j = 0; j < 8; ++j) uu[j] = hp[j]; }
            else {
#pragma unroll
                for (int j = 0; j < 8; ++j) uu[j] = 0.f; }
#pragma unroll
            for (int j = 0; j < 8; ++j) { acc[j] += scw[d * 512 + ch + j] * uu[j]; if (d == 2) uc[j] = uu[j]; }
        }
        float gb[8]; unpack8(*(const u32x4*)(P0 + (size_t)row * AB_IN + 768 + ch), gb);
#pragma unroll
        for (int j = 0; j < 8; ++j) acc[j] *= gb[j];
        *(u32x4*)(CAT + (size_t)row * DM + 512 + ch) = pack8(acc);
        if (t >= L - 2) { float* op = a.out + (row < MPR ? O_SCP + ((size_t)bb * 2 + (t - (L - 2))) * 512 : O_SCS + ((size_t)bb * 2 + (t - (L - 2))) * 512) + ch;
#pragma unroll
            for (int j = 0; j < 8; ++j) op[j] = uc[j]; }
    }
    for (int it = gt; it < (256 + 128) * 32; it += NGT) { const int ri = it >> 5, kvh = (it >> 4) & 1, dg = (it >> 1) & 7, isv = it & 1;
        int row, pos; float* op;
        if (ri < 256) { const int bb = ri >> 7, j = ri & 127; pos = SEQ - 128 + j; row = bb * SEQ + pos; op = a.out + (isv ? O_VP : O_KP) + ((size_t)(bb * 128 + j) * 2 + kvh) * 64 + dg * 8; }
        else { const int r2 = ri - 256, bb = r2 >> 4, j = r2 & 15; pos = 4096 + j; row = MPR + r2; op = a.out + (isv ? O_VS : O_KS) + ((size_t)(bb * 16 + j) * 2 + kvh) * 64 + dg * 8; }
        const bf16* rp = P0 + (size_t)row * AB_IN; float f[8];
        if (isv) unpack8(*(const u32x4*)(rp + 640 + kvh * 64 + dg * 8), f); else load8_rope(rp + 512 + kvh * 64, dg, rope + pos * 8, f);
        *(f32x4*)op = (f32x4){f[0], f[1], f[2], f[3]}; *(f32x4*)(op + 4) = (f32x4){f[4], f[5], f[6], f[7]};
    }
}

__device__ __forceinline__ void conv16(bf16* p, const float (&w0)[8], const float (&w1)[8], const float (&w2)[8], const float (&w3)[8], const float (&bz)[8], float (&h0)[8], float (&h1)[8], float (&h2)[8]) {
#pragma unroll
    for (int r = 0; r < 16; r += 8) {
        u32x4 raw[8];
#pragma unroll
        for (int q = 0; q < 8; ++q) raw[q] = *(const u32x4*)(p + (size_t)(r + q) * XBCW);
#pragma unroll
        for (int q = 0; q < 8; ++q) { float cur[8], y[8]; unpack8(raw[q], cur);
#pragma unroll
            for (int j = 0; j < 8; ++j) { y[j] = silu(w0[j] * h0[j] + w1[j] * h1[j] + w2[j] * h2[j] + w3[j] * cur[j] + bz[j]); h0[j] = h1[j]; h1[j] = h2[j]; h2[j] = cur[j]; }
            *(u32x4*)(p + (size_t)(r + q) * XBCW) = pack8(y); }
    }
}
__device__ __forceinline__ void ssmconv_phase(const Args& a, int G, int bid) {
    const int tid = threadIdx.x, gt = bid * NTHR + tid, NGT = G * NTHR;
    bf16* XBC = (bf16*)(a.ws + WS_XBC); const bf16* HALO = (const bf16*)(a.ws + WS_HALO);
    const float* cw = a.in[I_SSMCW]; const float* cb = a.in[I_SSMCB];
    for (int base = bid * NTHR; base < 256 * 384 * 4; base += G * NTHR) {
        const int it = base + tid, qtr = it & 3, q = it >> 2, blk = q / 384, col = (q - blk * 384) * 8, r0 = blk * 64 + qtr * 16;
        float h0[8], h1[8], h2[8], w0[8], w1[8], w2[8], w3[8], bz[8];
#pragma unroll
        for (int j = 0; j < 8; ++j) { h0[j] = 0.f; h1[j] = 0.f; h2[j] = 0.f; w0[j] = cw[col + j]; w1[j] = cw[XBCW + col + j]; w2[j] = cw[2 * XBCW + col + j]; w3[j] = cw[3 * XBCW + col + j]; bz[j] = cb[col + j]; }
        bf16* p = XBC + (size_t)r0 * XBCW + col;
        if (qtr) { unpack8(*(const u32x4*)(p - 3 * XBCW), h0); unpack8(*(const u32x4*)(p - 2 * XBCW), h1); unpack8(*(const u32x4*)(p - XBCW), h2); }
        else if (blk & 127) { const bf16* hal = HALO + (size_t)(blk - 1) * 3 * XBCW + col; unpack8(*(const u32x4*)hal, h0); unpack8(*(const u32x4*)(hal + XBCW), h1); unpack8(*(const u32x4*)(hal + 2 * XBCW), h2); }
        asm volatile("s_waitcnt vmcnt(0)" ::: "memory");
        __syncthreads();
        conv16(p, w0, w1, w2, w3, bz, h0, h1, h2);
        if (qtr == 3 && (blk & 127) == 127) { float* outc = a.out + O_CCP + (size_t)(blk >> 7) * 3 * XBCW + col;
#pragma unroll
            for (int j = 0; j < 8; ++j) { outc[j] = h0[j]; outc[XBCW + j] = h1[j]; outc[2 * XBCW + j] = h2[j]; } }
    }
    for (int v = (tid < 12 ? bid * 12 + tid : 8 * 384); v < 8 * 384; v += G * 12) {
        const int bs = v / 384, col = (v - bs * 384) * 8;
        const float* hist = a.in[I_SSMCONV] + (size_t)bs * 3 * XBCW + col; float* outc = a.out + O_CCS + (size_t)bs * 3 * XBCW + col;
        float h0[8], h1[8], h2[8], w0[8], w1[8], w2[8], w3[8], bz[8];
#pragma unroll
        for (int j = 0; j < 8; ++j) { h0[j] = hist[j]; h1[j] = hist[XBCW + j]; h2[j] = hist[2 * XBCW + j]; w0[j] = cw[col + j]; w1[j] = cw[XBCW + col + j]; w2[j] = cw[2 * XBCW + col + j]; w3[j] = cw[3 * XBCW + col + j]; bz[j] = cb[col + j]; }
        conv16(XBC + (size_t)(MPR + bs * 16) * XBCW + col, w0, w1, w2, w3, bz, h0, h1, h2);
#pragma unroll
        for (int j = 0; j < 8; ++j) { outc[j] = h0[j]; outc[XBCW + j] = h1[j]; outc[2 * XBCW + j] = h2[j]; }
    }
    float* DT = (float*)(a.ws + WS_DT); const float* dtb = a.in[I_DTB];
    for (int it = gt; it < MV * 32; it += NGT) { const float x = DT[it] + dtb[it & 31]; const float e = __expf(x);
        DT[it] = x > 20.f ? x : (e < 1e-2f ? e * (1.f - e * (0.5f - e * 0.33333333f)) : __logf(1.f + e)); }
}

constexpr int S_XS = 0, S_XW = 9216, S_BM = 18432, S_CM = 35840, S_HA = 53248, S_SC = 70656;
template <bool FULL>
__device__ __forceinline__ void ssd_stream(const Args& a, LAS unsigned char* lds, f32x4 (&st)[2][2], const int row0, const int nchunks, const int nvalid, const int h, const float a_h, const float d_h, float& logdec) {
    LAS bf16* Xs = (LAS bf16*)(lds + S_XS); LAS bf16* Xw = (LAS bf16*)(lds + S_XW); LAS bf16* Bm = (LAS bf16*)(lds + S_BM);
    LAS bf16* Cm = (LAS bf16*)(lds + S_CM); LAS bf16* HA = (LAS bf16*)(lds + S_HA); LAS float* scal0 = (LAS float*)(lds + S_SC);
    const int tid = threadIdx.x, lane = tid & 63, w = tid >> 6, fr = lane & 15, fq = lane >> 4, nq4 = w & 3, pr = w >> 2, g = h >> 3, lt = w & 3;
    const bf16* XBC = (const bf16*)(a.ws + WS_XBC); bf16* Z = (bf16*)(a.ws + WS_Z); const float* DT = (const float*)(a.ws + WS_DT);
    u32x4 px, pb[2], pc[2]; float pdt = 0.f;
    const u32x4 zero4 = (u32x4){0u, 0u, 0u, 0u};
    const int xl = tid >> 3, xpg = tid & 7;
    const bool lv = lane < nvalid;
#define SSD_PREFETCH(ci) do { const int rb_ = row0 + 64 * (ci); \
        px = xl < nvalid ? *(const u32x4*)(XBC + (size_t)(rb_ + xl) * XBCW + h * 64 + xpg * 8) : zero4; \
        _Pragma("unroll") for (int k_ = 0; k_ < 2; ++k_) { const int item_ = tid + NTHR * k_, l_ = item_ >> 4, ng_ = item_ & 15; \
            pb[k_] = l_ < nvalid ? *(const u32x4*)(XBC + (size_t)(rb_ + l_) * XBCW + 2048 + g * 128 + ng_ * 8) : zero4; \
            if (FULL) pc[k_] = l_ < nvalid ? *(const u32x4*)(XBC + (size_t)(rb_ + l_) * XBCW + 2560 + g * 128 + ng_ * 8) : zero4; } } while (0)
#define SSD_DTLOAD(ci) do { pdt = (lv && (ci) < nchunks) ? DT[(size_t)(row0 + 64 * (ci) + lane) * 32 + h] : 0.f; } while (0)
#define SSD_SCAN(buf) do { LAS float* sc_ = scal0 + 320 * (buf); const float dtl_ = pdt; float v_ = dtl_ * a_h; \
        _Pragma("unroll") for (int o_ = 1; o_ < 64; o_ <<= 1) { const float t_ = __shfl_up(v_, o_); if (lane >= o_) v_ += t_; } \
        const float tot_ = __shfl(v_, 63); sc_[lane] = v_; sc_[64 + lane] = __expf(v_); sc_[128 + lane] = __expf(tot_ - v_) * dtl_; sc_[192 + lane] = dtl_; if (lane == 0) sc_[256] = tot_; } while (0)
    SSD_PREFETCH(0);
    if (w == 0) { SSD_DTLOAD(0); SSD_SCAN(0); SSD_DTLOAD(1); }
    __syncthreads();
    for (int ci = 0; ci < nchunks; ++ci) {
        const int rbase = row0 + 64 * ci;
        LAS float* scal = scal0 + 320 * (ci & 1);
        { const float dte = scal[128 + xl]; float f[8]; unpack8(px, f);
#pragma unroll
          for (int j = 0; j < 8; ++j) f[j] *= dte;
          *(LAS u32x4*)(Xw + xl * 72 + xpg * 8) = pack8(f);
          if (FULL) *(LAS u32x4*)(Xs + xl * 72 + xpg * 8) = px; }
#pragma unroll
        for (int k = 0; k < 2; ++k) { const int item = tid + NTHR * k, l = item >> 4, ng = item & 15;
            *(LAS u32x4*)(Bm + l * 136 + ng * 8) = pb[k];
            if (FULL) *(LAS u32x4*)(Cm + l * 136 + ng * 8) = pc[k]; }
        if (FULL) {
#pragma unroll
            for (int nt = 0; nt < 2; ++nt)
#pragma unroll
                for (int pt = 0; pt < 2; ++pt) { const f32x4 v = st[nt][pt]; u32x2 wv; wv.x = pk2(v[0], v[1]); wv.y = pk2(v[2], v[3]);
                    *(LAS u32x2*)(HA + (32 * pr + 16 * pt + fr) * 136 + 32 * nq4 + 16 * nt + 4 * fq) = wv; } }
        if (ci + 1 < nchunks) SSD_PREFETCH(ci + 1);
        __syncthreads();
        if (w == 0 && ci + 1 < nchunks) { SSD_SCAN((ci + 1) & 1); SSD_DTLOAD(ci + 2); }
        u32x2 zr[2]; const int l = 16 * lt + fr;
        if (FULL) {
#pragma unroll
            for (int k2 = 0; k2 < 2; ++k2) { zr[k2] = (u32x2){0u, 0u}; if (l < nvalid) zr[k2] = *(const u32x2*)(Z + (size_t)(rbase + l) * ZW + h * 64 + 16 * (2 * pr + k2) + 4 * fq); } }
        { const float tot = scal[256]; logdec += tot; const float dec = __expf(tot);
#pragma unroll
          for (int nt = 0; nt < 2; ++nt)
#pragma unroll
              for (int pt = 0; pt < 2; ++pt) st[nt][pt] = st[nt][pt] * dec;
#pragma unroll
          for (int ks = 0; ks < 2; ++ks) { bf16x8 af[2], bx[2];
#pragma unroll
              for (int t = 0; t < 2; ++t) { af[t] = trfrag(Bm, 136, 32 * ks, 32 * nq4 + 16 * t, lane); bx[t] = trfrag(Xw, 72, 32 * ks, 32 * pr + 16 * t, lane); }
#pragma unroll
              for (int nt = 0; nt < 2; ++nt)
#pragma unroll
                  for (int pt = 0; pt < 2; ++pt) st[nt][pt] = mfma16(af[nt], bx[pt], st[nt][pt]); } }
        if (FULL) {
            bf16x8 cf[4];
#pragma unroll
            for (int ks = 0; ks < 4; ++ks) cf[ks] = *(const LAS bf16x8*)(Cm + l * 136 + ks * 32 + fq * 8);
            const float al = scal[l];
            unsigned wpk[4][2];
#pragma unroll
            for (int s4 = 0; s4 < 4; ++s4) {
                wpk[s4][0] = 0u; wpk[s4][1] = 0u;
                if (s4 <= lt) { f32x4 acc = (f32x4){0.f, 0.f, 0.f, 0.f};
#pragma unroll
                    for (int ks = 0; ks < 4; ++ks) { const bf16x8 af = *(const LAS bf16x8*)(Bm + (16 * s4 + fr) * 136 + ks * 32 + fq * 8); acc = mfma16(af, cf[ks], acc); }
                    const f32x4 as = *(const LAS f32x4*)(scal + 16 * s4 + 4 * fq), ds = *(const LAS f32x4*)(scal + 192 + 16 * s4 + 4 * fq); float v[4];
#pragma unroll
                    for (int i = 0; i < 4; ++i) { const int s = 16 * s4 + 4 * fq + i; v[i] = s <= l ? acc[i] * __expf(al - as[i]) * ds[i] : 0.f; }
                    wpk[s4][0] = pk2(v[0], v[1]); wpk[s4][1] = pk2(v[2], v[3]); }
            }
            bf16x8 bw[2];
#pragma unroll
            for (int ks = 0; ks < 2; ++ks) { const u32x4 t = (u32x4){wpk[2 * ks][0], wpk[2 * ks][1], wpk[2 * ks + 1][0], wpk[2 * ks + 1][1]}; bw[ks] = __builtin_bit_cast(bf16x8, t); }
            const float e = scal[64 + l];
#pragma unroll
            for (int k2 = 0; k2 < 2; ++k2) { const int pt = 2 * pr + k2;
                f32x4 dg = (f32x4){0.f, 0.f, 0.f, 0.f}, of = dg;
#pragma unroll
                for (int ks = 0; ks < 2; ++ks) { const u32x2 lo = trd(Xs, 72, 32 * ks + 4 * fq, 16 * pt, lane), hi = trd(Xs, 72, 32 * ks + 16 + 4 * fq, 16 * pt, lane);
                    const u32x4 t = (u32x4){lo.x, lo.y, hi.x, hi.y}; dg = mfma16(__builtin_bit_cast(bf16x8, t), bw[ks], dg); }
#pragma unroll
                for (int ks = 0; ks < 4; ++ks) { const bf16x8 af = *(const LAS bf16x8*)(HA + (16 * pt + fr) * 136 + ks * 32 + fq * 8); of = mfma16(af, cf[ks], of); }
                const u32x2 xr = *(const LAS u32x2*)(Xs + l * 72 + 16 * pt + 4 * fq);
                const float zf[4] = {bflo(zr[k2].x), bfhi(zr[k2].x), bflo(zr[k2].y), bfhi(zr[k2].y)}, xf[4] = {bflo(xr.x), bfhi(xr.x), bflo(xr.y), bfhi(xr.y)}; float y[4];
#pragma unroll
                for (int i = 0; i < 4; ++i) y[i] = (dg[i] + of[i] * e + d_h * xf[i]) * silu(zf[i]);
                if (l < nvalid) { u32x2 wv; wv.x = pk2(y[0], y[1]); wv.y = pk2(y[2], y[3]); *(u32x2*)(Z + (size_t)(rbase + l) * ZW + h * 64 + 16 * pt + 4 * fq) = wv; } }
        }
        __syncthreads();
    }
#undef SSD_PREFETCH
#undef SSD_DTLOAD
#undef SSD_SCAN
}
__device__ __forceinline__ void ssd_pass_a(const Args& a, LAS unsigned char* lds, int G, int bid) {
    const int tid = threadIdx.x;
    float* SEG = (float*)(a.ws + WS_SEG); float* SEGD = (float*)(a.ws + WS_SEGD);
    for (int u = bid; u < 192; u += G) { const int bh = u / 3, seg = u - bh * 3, b = bh >> 5, h = bh & 31;
        f32x4 st[2][2];
#pragma unroll
        for (int i = 0; i < 2; ++i) { st[i][0] = (f32x4){0.f, 0.f, 0.f, 0.f}; st[i][1] = st[i][0]; }
        float logdec = 0.f; const float a_h = -__expf(a.in[I_ALOG][h]);
        ssd_stream<false>(a, lds, st, b * SEQ + seg * 2048, 32, 64, h, a_h, 0.f, logdec);
        f32x4* sp = (f32x4*)(SEG + (size_t)u * 8192);
#pragma unroll
        for (int i = 0; i < 2; ++i)
#pragma unroll
            for (int j = 0; j < 2; ++j) sp[(i * 2 + j) * NTHR + tid] = st[i][j];
        if (tid == 0) SEGD[u] = logdec;
    }
}
__device__ __forceinline__ void ssd_pass_b(const Args& a, LAS unsigned char* lds, int G, int bid) {
    const int tid = threadIdx.x, lane = tid & 63, w = tid >> 6, fr = lane & 15, fq = lane >> 4, nq4 = w & 3, pr = w >> 2;
    const float* SEG = (const float*)(a.ws + WS_SEG); const float* SEGD = (const float*)(a.ws + WS_SEGD);
    for (int u = bid; u < 512; u += G) {
        f32x4 st[2][2]; float logdec = 0.f;
        if (u < 256) { const int bh = u >> 2, seg = u & 3, b = bh >> 5, h = bh & 31;
#pragma unroll
            for (int i = 0; i < 2; ++i) { st[i][0] = (f32x4){0.f, 0.f, 0.f, 0.f}; st[i][1] = st[i][0]; }
            for (int s = 0; s < seg; ++s) { const float dec = __expf(SEGD[bh * 3 + s]); const f32x4* sp = (const f32x4*)(SEG + (size_t)(bh * 3 + s) * 8192);
#pragma unroll
                for (int i = 0; i < 2; ++i)
#pragma unroll
                    for (int j = 0; j < 2; ++j) st[i][j] = st[i][j] * dec + sp[(i * 2 + j) * NTHR + tid]; }
            const float a_h = -__expf(a.in[I_ALOG][h]), d_h = a.in[I_SSMD][h];
            ssd_stream<true>(a, lds, st, b * SEQ + seg * 2048, 32, 64, h, a_h, d_h, logdec);
            if (seg == 3) { float* op = a.out + O_SSP + (size_t)bh * 8192;
#pragma unroll
                for (int nt = 0; nt < 2; ++nt)
#pragma unroll
                    for (int pt = 0; pt < 2; ++pt) *(f32x4*)(op + (32 * pr + 16 * pt + fr) * 128 + 32 * nq4 + 16 * nt + 4 * fq) = st[nt][pt]; }
        } else { const int v = u - 256, bs = v >> 5, h = v & 31;
            const float* ip = a.in[I_SSM] + (size_t)v * 8192;
#pragma unroll
            for (int nt = 0; nt < 2; ++nt)
#pragma unroll
                for (int pt = 0; pt < 2; ++pt) st[nt][pt] = *(const f32x4*)(ip + (32 * pr + 16 * pt + fr) * 128 + 32 * nq4 + 16 * nt + 4 * fq);
            const float a_h = -__expf(a.in[I_ALOG][h]), d_h = a.in[I_SSMD][h];
            ssd_stream<true>(a, lds, st, MPR + bs * 16, 1, 16, h, a_h, d_h, logdec);
            float* op = a.out + O_SSS + (size_t)v * 8192;
#pragma unroll
            for (int nt = 0; nt < 2; ++nt)
#pragma unroll
                for (int pt = 0; pt < 2; ++pt) *(f32x4*)(op + (32 * pr + 16 * pt + fr) * 128 + 32 * nq4 + 16 * nt + 4 * fq) = st[nt][pt];
        }
    }
}
__device__ __forceinline__ void gnorm_phase(const Args& a, int G, int bid) {
    const int tid = threadIdx.x, lane = tid & 63, wave = tid >> 6, gw = bid * NWAVES + wave, NGW = G * NWAVES;
    bf16* Z = (bf16*)(a.ws + WS_Z); const float* ng = a.in[I_SSMNG];
    f32x4 g0[4], g1[4];
#pragma unroll
    for (int g = 0; g < 4; ++g) { g0[g] = *(const f32x4*)(ng + g * 512 + lane * 8); g1[g] = *(const f32x4*)(ng + g * 512 + lane * 8 + 4); }
    for (int row = gw; row < MV; row += NGW) {
        u32x4* p = (u32x4*)(Z + (size_t)row * ZW + lane * 8); u32x4 raw[4];
#pragma unroll
        for (int g = 0; g < 4; ++g) raw[g] = p[g * 64];
#pragma unroll
        for (int g = 0; g < 4; ++g) { float f[8]; unpack8(raw[g], f); float ss = 0.f;
#pragma unroll
            for (int j = 0; j < 8; ++j) ss += f[j] * f[j];
            const float r = __builtin_amdgcn_rsqf(wave_sum(ss) * (1.f / 512.f) + EPS);
            f[0] *= r * g0[g].x; f[1] *= r * g0[g].y; f[2] *= r * g0[g].z; f[3] *= r * g0[g].w; f[4] *= r * g1[g].x; f[5] *= r * g1[g].y; f[6] *= r * g1[g].z; f[7] *= r * g1[g].w;
            p[g * 64] = pack8(f); }
    }
}

__device__ __forceinline__ void sample_gemm(const bf16* A, const bf16* Bt, int K, bf16* out, LAS unsigned char* lds, int bid) {
    if (bid >= 64) return;
    const int tid = threadIdx.x, lane = tid & 63, w = tid >> 6, fr = lane & 15, fq = lane >> 4;
    const int row0 = MPR + 32 * (bid & 3), col0 = 64 * (bid >> 2), ksl = K >> 3, nst = ksl >> 5;
    const bf16* ap = A + (size_t)(row0 + fr) * K + w * ksl + 8 * fq;
    const bf16* bp = Bt + (size_t)(col0 + fr) * K + w * ksl + 8 * fq;
    f32x4 acc[2][4];
#pragma unroll
    for (int t = 0; t < 2; ++t)
#pragma unroll
        for (int c = 0; c < 4; ++c) acc[t][c] = (f32x4){0.f, 0.f, 0.f, 0.f};
    for (int s0 = 0; s0 < nst; s0 += 4) {
        bf16x8 af[4][2], bfm[4][4];
#pragma unroll
        for (int s = 0; s < 4; ++s) if (s0 + s < nst) {
#pragma unroll
            for (int t = 0; t < 2; ++t) af[s][t] = *(const bf16x8*)(ap + (size_t)(16 * t) * K + 32 * (s0 + s));
#pragma unroll
            for (int c = 0; c < 4; ++c) bfm[s][c] = *(const bf16x8*)(bp + (size_t)(16 * c) * K + 32 * (s0 + s)); }
#pragma unroll
        for (int s = 0; s < 4; ++s) if (s0 + s < nst) {
#pragma unroll
            for (int t = 0; t < 2; ++t)
#pragma unroll
                for (int c = 0; c < 4; ++c) acc[t][c] = mfma16(bfm[s][c], af[s][t], acc[t][c]); }
    }
    LAS f32x4* red = (LAS f32x4*)lds;
#pragma unroll
    for (int t = 0; t < 2; ++t)
#pragma unroll
        for (int c = 0; c < 4; ++c) red[(w * 8 + t * 4 + c) * 64 + lane] = acc[t][c];
    __syncthreads();
    f32x4 sum = red[w * 64 + lane];
#pragma unroll
    for (int v = 1; v < 8; ++v) sum = sum + red[(v * 8 + w) * 64 + lane];
    u32x2 wv; wv.x = pk2(sum[0], sum[1]); wv.y = pk2(sum[2], sum[3]);
    *(u32x2*)(out + (size_t)(row0 + 16 * (w >> 2) + fr) * DM + col0 + 16 * (w & 3) + 4 * fq) = wv;
    __syncthreads();
}

#define XB_TMO      128
#define XB_XCNT(j)  (256  + 64 * (j))
#define XB_XSUB(j)  (1280 + 64 * (j))
#define XB_XGEN(j)  (2304 + 64 * (j))
#define XB_TOP      3328
#define XB_TOPGEN   3392
#define XCD_BAR_WORDS 3456
#define XB_SPIN_CAP (1u << 18)

__device__ __forceinline__ unsigned xb_ld(unsigned* p)              { return __hip_atomic_load(p, __ATOMIC_RELAXED, __HIP_MEMORY_SCOPE_AGENT); }
__device__ __forceinline__ unsigned xb_add(unsigned* p, unsigned v) { return __hip_atomic_fetch_add(p, v, __ATOMIC_RELAXED, __HIP_MEMORY_SCOPE_AGENT); }
__device__ __forceinline__ unsigned xb_xcc_id() { return (unsigned)__builtin_amdgcn_s_getreg((3 << 11) | 20) & 0xFu; }
#define XB_SPIN(cond, bar) do { unsigned _sp = 0; while (cond) { __builtin_amdgcn_s_sleep(1); \
    if ((++_sp & 255u) == 0u) { if (xb_ld(&(bar)[XB_TMO])) break; if (_sp > XB_SPIN_CAP) { atomicAdd(&(bar)[XB_TMO], 1u); break; } } } } while (0)

struct XcdBarrier {
    unsigned* bar; unsigned x;
    volatile LAS unsigned* st;
};

__device__ __forceinline__ XcdBarrier xcd_barrier_post(unsigned* bar, volatile LAS unsigned* st) {
    XcdBarrier b; b.bar = bar; b.x = xb_xcc_id(); b.st = st;
    if (threadIdx.x == 0) (void)xb_add(&bar[XB_XCNT(b.x)], 1u);
    return b;
}
__device__ __forceinline__ void xcd_barrier_complete(unsigned* bar, unsigned x, unsigned& nloc, unsigned& nx) {
    const unsigned G = gridDim.x * gridDim.y * gridDim.z;
    unsigned sum, cnt, mine, sp = 0u;
    for (;;) {
        sum = 0u; cnt = 0u; mine = 0u;
#pragma unroll
        for (unsigned j = 0; j < 16; ++j) { const unsigned c = xb_ld(&bar[XB_XCNT(j)]); sum += c; cnt += (c > 0u) ? 1u : 0u; mine = (j == x) ? c : mine; }
        if (sum == G) break;
        __builtin_amdgcn_s_sleep(1);
        if ((++sp & 255u) == 0u) { if (xb_ld(&bar[XB_TMO])) break; if (sp > XB_SPIN_CAP) { atomicAdd(&bar[XB_TMO], 1u); break; } }
    }
    nloc = mine > 0u ? mine : 1u; nx = cnt > 0u ? cnt : 1u;
}

__device__ __forceinline__ void xcd_barrier(const XcdBarrier& b) {
    asm volatile("s_waitcnt vmcnt(0)" ::: "memory");
    __syncthreads();
    if (threadIdx.x == 0) {
        unsigned* bar = b.bar;
        __builtin_amdgcn_s_waitcnt(0);
        unsigned nloc = b.st[0], nx = b.st[1];
        if (nloc == 0u) { xcd_barrier_complete(bar, b.x, nloc, nx); b.st[0] = nloc; b.st[1] = nx; }
        const unsigned old = xb_add(&bar[XB_XSUB(b.x)], 1u);
        const unsigned gen = old / nloc;
        if (old + 1u == (gen + 1u) * nloc) {
            __builtin_amdgcn_fence(__ATOMIC_RELEASE, "agent");
            asm volatile("s_waitcnt vmcnt(0)" ::: "memory");
            const unsigned og = xb_add(&bar[XB_TOP], 1u);
            const unsigned tg = og / nx;
            if (og + 1u == (tg + 1u) * nx) xb_add(&bar[XB_TOPGEN], 1u);
            else XB_SPIN(xb_ld(&bar[XB_TOPGEN]) == tg, bar);
            __builtin_amdgcn_fence(__ATOMIC_ACQUIRE, "agent");
            xb_add(&bar[XB_XGEN(b.x)], 1u);
            asm volatile("s_waitcnt vmcnt(0)" ::: "memory");
        } else {
            XB_SPIN(xb_ld(&bar[XB_XGEN(b.x)]) == gen, bar);
            __builtin_amdgcn_fence(__ATOMIC_ACQUIRE, "agent");
            asm volatile("s_waitcnt vmcnt(0)" ::: "memory");
        }
    }
    __syncthreads();
}


__device__ __forceinline__ void nrn_final(const Args& a, const float* g1, int G, int bid, const XcdBarrier& bar) {
    const int tid = threadIdx.x, lane = tid & 63, wave = tid >> 6;
    const int gw = bid * NWAVES + wave, NGW = G * NWAVES;
    const bf16* mix = (const bf16*)(a.ws + WS_MIX); const bf16* xr = (const bf16*)((const unsigned char*)a.out + XR_BYTE_OFF);
    const f32x4* g14 = (const f32x4*)g1;
    constexpr int NIT = 9;
    u32x2 xw[NIT][4];
#pragma unroll
    for (int k = 0; k < NIT; ++k) { const int row = gw + k * NGW;
#pragma unroll
        for (int j = 0; j < 4; ++j) xw[k][j] = row < MV ? ((const u32x2*)(xr + (size_t)row * DM))[lane + 64 * j] : (u32x2){0u, 0u}; }
    xcd_barrier(bar);
#pragma unroll
    for (int k = 0; k < NIT; ++k) { const int row = gw + k * NGW;
        if (row < MV) {
            const u32x2* mp = (const u32x2*)(mix + (size_t)row * DM); f32x4* yp = (f32x4*)(a.out + (size_t)row * DM);
            f32x4 m[4]; float ss = 0.f;
#pragma unroll
            for (int j = 0; j < 4; ++j) { const u32x2 w = mp[lane + 64 * j]; m[j] = (f32x4){bflo(w.x), bfhi(w.x), bflo(w.y), bfhi(w.y)}; ss += (m[j].x * m[j].x + m[j].y * m[j].y) + (m[j].z * m[j].z + m[j].w * m[j].w); }
            const float r1 = __builtin_amdgcn_rsqf(wave_sum(ss) * (1.f / DM) + EPS);
#pragma unroll
            for (int j = 0; j < 4; ++j) { const f32x4 g = g14[lane + 64 * j]; const f32x4 xv = (f32x4){bflo(xw[k][j].x), bfhi(xw[k][j].x), bflo(xw[k][j].y), bfhi(xw[k][j].y)}; yp[lane + 64 * j] = xv + m[j] * r1 * g; }
        } }
}

#ifndef MK_ONE_LAUNCH
#define MK_ONE_LAUNCH 1
#endif
constexpr int N_PHASES = 18;
__global__ void __launch_bounds__(NTHR, 2) mega_fwd(Args args) {
    extern __shared__ __attribute__((aligned(16))) unsigned char lds_raw[];
    LAS unsigned char* lds = (LAS unsigned char*)lds_raw;
    cg::grid_group grid = cg::this_grid();
    volatile LAS unsigned* MISC = (volatile LAS unsigned*)(lds + 131072 + 320);
    if (threadIdx.x < 32) MISC[threadIdx.x] = 0u;
    __syncthreads();
    XcdBarrier bar = xcd_barrier_post((unsigned*)(args.ws + WS_BAR), MISC + 8);
    if (args.ph_lo > args.ph_hi) grid.sync();
    const int G = gridDim.x, bid = blockIdx.x;
    unsigned char* ws = args.ws;
    const int lo = args.ph_lo, hi = args.ph_hi;
    const float* NG = args.in[I_NG];
    bf16* XN = (bf16*)(ws + WS_XN); bf16* MIX = (bf16*)(ws + WS_MIX); bf16* HB = (bf16*)(ws + WS_H);
#ifndef PROBE_DBL
#define PROBE_DBL 0
#endif
#define IN(k) (lo <= (k) && (k) < hi)
#define PH(k, ...) if (IN(k)) { __VA_ARGS__ if ((PROBE_DBL >> (k)) & 1) { __VA_ARGS__ } }
#ifndef PROBE_SYNCS
#define PROBE_SYNCS 0
#endif
#define SEAM(k) do { if (IN(k) && IN((k) + 1)) { xcd_barrier(bar); if ((k) == 4) for (int q_ = 0; q_ < PROBE_SYNCS; ++q_) xcd_barrier(bar); } } while (0)
#define GEMM_SPLIT(Aptr, Wptr, NN, KK, E) do { pg8::Gemm g_{(const pg8::bf16_t*)(Aptr), (const pg8::bf16_t*)(Wptr), MPAD, (NN), (KK)}; pg8::StaticOrder S_; S_.init(MPAD, (NN), G, bid); \
        pg8::gemm_phase<pg8::EpiSplit, pg8::StaticOrder, true, true>(lds, g_, S_, E); } while (0)
#define GEMM_N1024(Aptr, Wptr, KK) do { pg8::EpiSplit E_{MIX, DM, DM, nullptr, 0, DM, nullptr, 0, nullptr}; pg8::Gemm g_{(const pg8::bf16_t*)(Aptr), (const pg8::bf16_t*)(Wptr), MPR, DM, (KK)}; pg8::StaticOrder S_; S_.init(MPR, DM, G, bid); \
        pg8::gemm_phase<pg8::EpiSplit, pg8::StaticOrder, true, true>(lds, g_, S_, E_); sample_gemm((const bf16*)(Aptr), (const bf16*)(Wptr), (KK), MIX, lds, bid); } while (0)
#define GEMM_SWIGLU(Aptr, Wptr, E) do { pg8::Gemm g_{(const pg8::bf16_t*)(Aptr), (const pg8::bf16_t*)(Wptr), MPAD, 2 * DFF, DM}; pg8::StaticOrder S_; S_.init(MPAD, 2 * DFF, G, bid); \
        pg8::gemm_phase<pg8::EpiSwiGLU, pg8::StaticOrder, true, true>(lds, g_, S_, E); } while (0)
    PH(0, p0_prologue(args, lds, G, bid);) SEAM(0);
    PH(1, pg8::EpiSplit E{(bf16*)(ws + WS_P0), AB_IN, AB_IN, nullptr, 0, AB_IN, nullptr, 0, nullptr}; GEMM_SPLIT(XN, ws + WS_W_ABIN, AB_IN, DM, E);) SEAM(1);
    PH(2, attn_phase(args, lds, G, bid);) SEAM(2);
    PH(3, GEMM_N1024(ws + WS_CAT, ws + WS_W_ABOUT, DM);) SEAM(3);
    PH(4, nrn_mid<true>(args, NG + 1 * DM, NG + 2 * DM, G, bid);) SEAM(4);
    PH(5, pg8::EpiSwiGLU E{HB, DFF}; GEMM_SWIGLU(XN, ws + WS_W_UP0, E);) SEAM(5);
    PH(6, GEMM_N1024(HB, ws + WS_W_DN0, DFF);) SEAM(6);
    PH(7, nrn_mid<false>(args, NG + 3 * DM, NG + 4 * DM, G, bid);) SEAM(7);
    PH(8, pg8::EpiSplit E{(bf16*)(ws + WS_Z), ZW, ZW, (bf16*)(ws + WS_XBC), XBCW, ZW + XBCW, (float*)(ws + WS_DT), 32, (bf16*)(ws + WS_HALO)}; GEMM_SPLIT(XN, ws + WS_W_SSMIN, SSM_INP, DM, E);) SEAM(8);
    PH(9, ssmconv_phase(args, G, bid);) SEAM(9);
    PH(10, ssd_pass_a(args, lds, G, bid);) SEAM(10);
    PH(11, ssd_pass_b(args, lds, G, bid);) SEAM(11);
    PH(12, gnorm_phase(args, G, bid);) SEAM(12);
    PH(13, GEMM_N1024(ws + WS_Z, ws + WS_W_SSMOUT, ZW);) SEAM(13);
    PH(14, nrn_mid<false>(args, NG + 5 * DM, NG + 6 * DM, G, bid);) SEAM(14);
    PH(15, pg8::EpiSwiGLU E{HB, DFF}; GEMM_SWIGLU(XN, ws + WS_W_UP1, E);) SEAM(15);
    PH(16, GEMM_N1024(HB, ws + WS_W_DN1, DFF);) SEAM(16);
    if (IN(17)) nrn_final(args, NG + 7 * DM, G, bid, bar);
#undef IN
#undef SEAM
}

extern "C" void kernel_launch(void* const* d_in, const int* in_sizes, int n_in, void* d_out, int out_size, void* d_ws, size_t ws_size, hipStream_t stream) {
    static int grid = 0;
    if (grid == 0) {
        if (n_in != 23 || out_size != (int)O_END || ws_size < WS_END) { fprintf(stderr, "kernel_launch: unexpected shapes (n_in %d out %d ws %zu)\n", n_in, out_size, ws_size); grid = -1; return; }
        int dev = 0, cus = 0, per_cu = 0;
        (void)hipGetDevice(&dev); (void)hipDeviceGetAttribute(&cus, hipDeviceAttributeMultiprocessorCount, dev);
        if (hipFuncSetAttribute((const void*)mega_fwd, hipFuncAttributeMaxDynamicSharedMemorySize, LDS_BYTES) != hipSuccess) { fprintf(stderr, "kernel_launch: hipFuncSetAttribute failed\n"); grid = -1; return; }
        if (hipOccupancyMaxActiveBlocksPerMultiprocessor(&per_cu, (const void*)mega_fwd, NTHR, LDS_BYTES) != hipSuccess || per_cu < 1) { fprintf(stderr, "kernel_launch: occupancy query gave %d\n", per_cu); per_cu = 1; }
        (void)hipGetLastError();
        grid = cus * 1;
        if (grid != 256) { fprintf(stderr, "kernel_launch: built for a 256-CU device (got %d)\n", grid); grid = -1; return; }
    }
    if (grid < 0) return;
    Args a{};
    for (int i = 0; i < 23; ++i) a.in[i] = (const float*)d_in[i];
    a.out = (float*)d_out; a.ws = (unsigned char*)d_ws;
    if (hipMemsetAsync((char*)d_ws + WS_BAR, 0, BAR_BYTES, stream) != hipSuccess) { fprintf(stderr, "kernel_launch: memset failed\n"); return; }
#if MK_ONE_LAUNCH
    a.ph_lo = 0; a.ph_hi = N_PHASES;
    void* kargs[] = {&a};
    hipError_t e = hipLaunchCooperativeKernel((const void*)mega_fwd, dim3(grid), dim3(NTHR), kargs, LDS_BYTES, stream);
    if (e != hipSuccess) fprintf(stderr, "kernel_launch: cooperative launch failed: %s (grid %d)\n", hipGetErrorString(e), grid);
#else
    for (int p = 0; p < N_PHASES; ++p) { a.ph_lo = p; a.ph_hi = p + 1; hipLaunchKernelGGL(mega_fwd, dim3(grid), dim3(NTHR), LDS_BYTES, stream, a); }
#endif
}
```

```cpp
#include <hip/hip_runtime.h>
#include <hip/hip_cooperative_groups.h>
#include <cstdio>
#include <cstdint>
namespace cg = cooperative_groups;
#define MK_ONE_LAUNCH 1
namespace pg8 {
#define PG8_LAS __attribute__((address_space(3)))
typedef unsigned short bf16_t;
typedef short bf16x8 __attribute__((ext_vector_type(8)));
typedef float f32x4 __attribute__((ext_vector_type(4)));
typedef unsigned u32x4 __attribute__((ext_vector_type(4)));
constexpr int BM = 256, BK = 64, HALF = 128, HTB = HALF * BK * 2  , STAGE_BYTES = 8 * HTB, NXCD = 8, WGM = 8;

__host__ __device__ __forceinline__ int lds_byte(int r, int c) { const int st = (r >> 4) * 2 + (c >> 5), rr = r & 15, cc = c & 31, ob = rr * 64 + cc * 2; return st * 1024 + (ob ^ (((ob >> 9) & 1) << 5)); }
__host__ __device__ __forceinline__ void stage_rc(int b, int& R, int& C) { const int st = b / 1024, sb = b % 1024, swz = sb ^ (((sb >> 9) & 1) << 5); R = (st >> 1) * 16 + swz / 64; C = (st & 1) * 32 + (swz % 64) / 2; }
__host__ __device__ __forceinline__ int perm32(int rho) { const int n = rho >> 4, i = rho & 15; return 8 * (i >> 2) + 4 * n + (i & 3); }

struct Unit { int pm, pn; };
struct Gemm { const bf16_t* A; const bf16_t* Bt; int M, N, K; };

struct StaticOrder {
    int nM, nN, nwg, G, c;
    __host__ __device__ void init(int M, int N, int G_, int c_) { nM = M / BM; nN = N / BM; nwg = nM * nN; G = G_; c = c_; }
    __host__ __device__ bool next(int i, Unit& u) const {
        const long L = (long)i * G + c; if (L >= nwg) return false;
        int wgid = (int)L; { const int q = nwg / NXCD, r = nwg % NXCD, xcd = wgid % NXCD, off = wgid / NXCD; wgid = (xcd < r ? xcd * (q + 1) : r * (q + 1) + (xcd - r) * q) + off; }
        const int nig = WGM * nN, gid = wgid / nig, fm = gid * WGM, gsz = (nM - fm) < WGM ? (nM - fm) : WGM;
        u.pm = fm + ((wgid % nig) % gsz); u.pn = (wgid % nig) / gsz; return true;
    }
    __device__ __forceinline__ void a_ready(const Unit&) const {}
    __device__ __forceinline__ void done(const Unit&) const {}
};

__device__ __forceinline__ unsigned cvt_pk_bf16(float lo, float hi) { unsigned r; asm volatile("v_cvt_pk_bf16_f32 %0, %1, %2" : "=v"(r) : "v"(lo), "v"(hi)); return r; }
__device__ __forceinline__ float silu_f(float v) { return v * __builtin_amdgcn_rcpf(1.0f + __expf(-v)); }
struct EpiSplit {
    static constexpr bool PERM = true, AFTER_DRAIN = false;
    bf16_t* O0; int ld0; int c1; bf16_t* O1; int ld1; int c2; float* O2; int ld2; bf16_t* halo;
    __device__ __forceinline__ void operator()(const f32x4 (&acc)[2][2][4][2], const Unit& u, int wr, int wc, int fr, int fq) const {
        const int row0 = u.pm * BM + wr * 64 + fr; const int colt = u.pn * BM;
        if (colt >= c2) {
            if (wc == 0) {
#pragma unroll
                for (int ai = 0; ai < 2; ++ai)
#pragma unroll
                    for (int m = 0; m < 4; ++m) { float* rp = O2 + (size_t)(row0 + ai * HALF + m * 16) * ld2 + 8 * fq; *(f32x4*)rp = acc[ai][0][m][0]; *(f32x4*)(rp + 4) = acc[ai][0][m][1]; }
            }
            return;
        }
        bf16_t* base; int ld, cb; bool hal = false;
        if (colt < c1) { base = O0; ld = ld0; cb = colt; } else { base = O1; ld = ld1; cb = colt - c1; hal = (halo != nullptr); }
        const int col0 = cb + wc * 32 + 8 * fq;
#pragma unroll
        for (int ai = 0; ai < 2; ++ai)
#pragma unroll
            for (int m = 0; m < 4; ++m) { const int r = row0 + ai * HALF + m * 16; bf16_t* rowp = base + (size_t)r * ld + col0;
#pragma unroll
                for (int bj = 0; bj < 2; ++bj) { const f32x4 v0 = acc[ai][bj][m][0], v1 = acc[ai][bj][m][1];
                    u32x4 w; w.x = cvt_pk_bf16(v0[0], v0[1]); w.y = cvt_pk_bf16(v0[2], v0[3]); w.z = cvt_pk_bf16(v1[0], v1[1]); w.w = cvt_pk_bf16(v1[2], v1[3]);
                    *(u32x4*)(rowp + bj * HALF) = w;
                    if (m == 3 && hal && fr >= 13) *(u32x4*)(halo + (size_t)((r >> 6) * 3 + (fr - 13)) * ld1 + col0 + bj * HALF) = w; } }
    }
};
struct EpiSwiGLU {
    static constexpr bool PERM = false, AFTER_DRAIN = false;
    bf16_t* H; int ldh;
    __device__ __forceinline__ void operator()(const f32x4 (&acc)[2][2][4][2], const Unit& u, int wr, int wc, int fr, int fq) const {
        const int row0 = u.pm * BM + wr * 64 + fr; const int hcol0 = (u.pn * BM + wc * 32) / 2 + 4 * fq;
        typedef unsigned u32x2v __attribute__((ext_vector_type(2)));
#pragma unroll
        for (int ai = 0; ai < 2; ++ai)
#pragma unroll
            for (int m = 0; m < 4; ++m) { bf16_t* rowp = H + (size_t)(row0 + ai * HALF + m * 16) * ldh + hcol0;
#pragma unroll
                for (int bj = 0; bj < 2; ++bj) { const f32x4 g = acc[ai][bj][m][0], up = acc[ai][bj][m][1];
                    u32x2v w; w.x = cvt_pk_bf16(silu_f(g[0]) * up[0], silu_f(g[1]) * up[1]); w.y = cvt_pk_bf16(silu_f(g[2]) * up[2], silu_f(g[3]) * up[3]);
                    *(u32x2v*)(rowp + bj * 64) = w; } }
    }
};
template <class Epi, class Sched, bool ALIGN_EPI = false, bool SP2 = false>
__device__ __forceinline__ void gemm_phase(PG8_LAS unsigned char* lds, const Gemm g, const Sched& S, const Epi& E) {
    const int tid = threadIdx.x, wid = __builtin_amdgcn_readfirstlane(tid >> 6), lane = tid & 63, wr = wid >> 2, wc = wid & 3, fr = lane & 15, fq = lane >> 4;
    const int K = g.K, nt = K / BK;
    unsigned voffA[2], voffB[2];
#pragma unroll
    for (int i = 0; i < 2; ++i) { int R, C; stage_rc(tid * 16 + i * 8192, R, C); const int Rb = Epi::PERM ? ((R & ~31) + perm32(R & 31)) : R;
        voffA[i] = (unsigned)(R * K + C) * 2u; voffB[i] = (unsigned)(Rb * K + C) * 2u; }
    const size_t kstep = (size_t)(BK * 2);
    const size_t hstep = (size_t)HALF * K * 2;
    const size_t tstep = 2 * hstep;
    const unsigned ldsw = (unsigned)wid * 1024u;
    const int aoff = lds_byte(wr * 64 + fr, fq * 8), boff = lds_byte(wc * 32 + fr, fq * 8);
#define PG8_SA(b, h) (((b) * 2 + (h)) * HTB)
#define PG8_SB(b, h) ((4 + (b) * 2 + (h)) * HTB)
#define PG8_STAGE(bufoff, gbase, voff) do { _Pragma("unroll") for (int _i = 0; _i < 2; ++_i) \
        __builtin_amdgcn_global_load_lds((const unsigned*)((const char*)(gbase) + (voff)[_i]), (PG8_LAS unsigned*)(lds + (bufoff) + ldsw + _i * 8192), 16, 0, 0); } while (0)
#define PG8_LDA(dst, b, h) do { _Pragma("unroll") for (int m = 0; m < 4; ++m) _Pragma("unroll") for (int k = 0; k < 2; ++k) dst[m][k] = *(const PG8_LAS bf16x8*)(lds + PG8_SA(b, h) + aoff + m * 2048 + k * 1024); } while (0)
#define PG8_LDB(dst, b, h) do { _Pragma("unroll") for (int n = 0; n < 2; ++n) _Pragma("unroll") for (int k = 0; k < 2; ++k) dst[n][k] = *(const PG8_LAS bf16x8*)(lds + PG8_SB(b, h) + boff + n * 2048 + k * 1024); } while (0)
#define PG8_MMA(ai, bj, At, Bt) do { __builtin_amdgcn_s_setprio(1); _Pragma("unroll") for (int m = 0; m < 4; ++m) _Pragma("unroll") for (int n = 0; n < 2; ++n) _Pragma("unroll") for (int k = 0; k < 2; ++k) \
        acc[ai][bj][m][n] = __builtin_amdgcn_mfma_f32_16x16x32_bf16(Bt[n][k], At[m][k], acc[ai][bj][m][n], 0, 0, 0); __builtin_amdgcn_s_setprio(0); } while (0)
#define PG8_WAIT_V(n) asm volatile("s_waitcnt vmcnt(" #n ")" ::: "memory")
#define PG8_WAIT_L(n) asm volatile("s_waitcnt lgkmcnt(" #n ")" ::: "memory")
#define PG8_BAR __builtin_amdgcn_s_barrier()
#define PG8_SCHED __builtin_amdgcn_sched_barrier(0)
    Unit cur, nxt; int ui = 0;
    if (!S.next(0, cur)) return;
    f32x4 acc[2][2][4][2];
#pragma unroll
    for (int a = 0; a < 2; ++a)
#pragma unroll
        for (int b = 0; b < 2; ++b)
#pragma unroll
            for (int m = 0; m < 4; ++m)
#pragma unroll
                for (int n = 0; n < 2; ++n) acc[a][b][m][n] = (f32x4){0.f, 0.f, 0.f, 0.f};
    bf16x8 At[4][2], B0[2][2], B1[2][2];
    const char* cA = (const char*)g.A + (size_t)cur.pm * tstep; const char* cB = (const char*)g.Bt + (size_t)cur.pn * tstep;
    S.a_ready(cur);
    if constexpr (SP2) {
        PG8_STAGE(PG8_SB(0, 0), cB, voffB); PG8_STAGE(PG8_SB(0, 1), cB + hstep, voffB); PG8_STAGE(PG8_SA(0, 0), cA, voffA); PG8_STAGE(PG8_SA(0, 1), cA + hstep, voffA);
        if (wr == 1) PG8_BAR;
        PG8_WAIT_V(2); PG8_BAR;
        PG8_STAGE(PG8_SB(1, 0), cB + kstep, voffB); PG8_STAGE(PG8_SA(1, 0), cA + kstep, voffA); PG8_STAGE(PG8_SB(1, 1), cB + hstep + kstep, voffB);
        PG8_WAIT_V(6); PG8_BAR;
    } else {
        PG8_STAGE(PG8_SB(0, 0), cB, voffB); PG8_STAGE(PG8_SA(0, 0), cA, voffA); PG8_STAGE(PG8_SB(0, 1), cB + hstep, voffB); PG8_STAGE(PG8_SA(0, 1), cA + hstep, voffA);
        if (wr == 1) PG8_BAR;
        PG8_WAIT_V(4); PG8_BAR;
        PG8_STAGE(PG8_SB(1, 0), cB + kstep, voffB); PG8_STAGE(PG8_SA(1, 0), cA + kstep, voffA); PG8_STAGE(PG8_SB(1, 1), cB + hstep + kstep, voffB);
        PG8_WAIT_V(6); PG8_BAR;
    }
    for (;;) {
        const bool has_next = S.next(ui + 1, nxt);
        const char* nA = has_next ? (const char*)g.A + (size_t)nxt.pm * tstep : cA; const char* nB = has_next ? (const char*)g.Bt + (size_t)nxt.pn * tstep : cB;
        for (int t = 0; t < nt; t += 2) {
            const bool last = (t == nt - 2);
            const char* a1 = cA + (size_t)(t + 1) * kstep;
            const char* a2 = last ? nA : cA + (size_t)(t + 2) * kstep; const char* b2 = last ? nB : cB + (size_t)(t + 2) * kstep;
            const char* a3 = a2 + kstep; const char* b3 = b2 + kstep;
            if (last && has_next) S.a_ready(nxt);
            if constexpr (SP2) {
            PG8_LDB(B0, 0, 0); PG8_LDB(B1, 0, 1); PG8_SCHED; PG8_LDA(At, 0, 0); PG8_STAGE(PG8_SA(1, 1), a1 + hstep, voffA);
            PG8_WAIT_V(8); PG8_WAIT_L(0); PG8_BAR; PG8_MMA(0, 0, At, B0); PG8_MMA(0, 1, At, B1); PG8_BAR; PG8_SCHED;
            PG8_LDA(At, 0, 1); PG8_STAGE(PG8_SB(0, 0), b2, voffB); PG8_STAGE(PG8_SB(0, 1), b2 + hstep, voffB); PG8_STAGE(PG8_SA(0, 0), a2, voffA);
            PG8_WAIT_V(8); PG8_WAIT_L(0); PG8_BAR; PG8_MMA(1, 0, At, B0); PG8_MMA(1, 1, At, B1); PG8_BAR; PG8_SCHED;
            PG8_LDB(B0, 1, 0); PG8_LDB(B1, 1, 1); PG8_SCHED; PG8_LDA(At, 1, 0); PG8_STAGE(PG8_SA(0, 1), a2 + hstep, voffA);
            PG8_WAIT_V(8); PG8_WAIT_L(0); PG8_BAR; PG8_MMA(0, 0, At, B0); PG8_MMA(0, 1, At, B1); PG8_BAR; PG8_SCHED;
            PG8_LDA(At, 1, 1); PG8_STAGE(PG8_SB(1, 0), b3, voffB); PG8_STAGE(PG8_SB(1, 1), b3 + hstep, voffB); PG8_STAGE(PG8_SA(1, 0), a3, voffA);
            PG8_WAIT_V(8); PG8_WAIT_L(0); PG8_BAR; PG8_MMA(1, 0, At, B0); PG8_MMA(1, 1, At, B1); PG8_BAR; PG8_SCHED;
            } else {
            PG8_LDB(B0, 0, 0); PG8_SCHED; PG8_LDA(At, 0, 0); PG8_STAGE(PG8_SA(1, 1), a1 + hstep, voffA);
            PG8_WAIT_L(8); PG8_BAR; PG8_WAIT_L(0); PG8_MMA(0, 0, At, B0); PG8_BAR; PG8_SCHED;
            PG8_LDB(B1, 0, 1); PG8_STAGE(PG8_SB(0, 0), b2, voffB);
            PG8_BAR; PG8_WAIT_L(0); PG8_MMA(0, 1, At, B1); PG8_BAR;
            PG8_LDA(At, 0, 1); PG8_STAGE(PG8_SA(0, 0), a2, voffA);
            PG8_BAR; PG8_WAIT_L(0); PG8_MMA(1, 0, At, B0); PG8_BAR; PG8_SCHED;
            PG8_STAGE(PG8_SB(0, 1), b2 + hstep, voffB);
            PG8_WAIT_V(6); PG8_BAR; PG8_MMA(1, 1, At, B1); PG8_BAR;
            PG8_LDB(B0, 1, 0); PG8_SCHED; PG8_LDA(At, 1, 0); PG8_STAGE(PG8_SA(0, 1), a2 + hstep, voffA);
            PG8_WAIT_L(8); PG8_BAR; PG8_WAIT_L(0); PG8_MMA(0, 0, At, B0); PG8_BAR; PG8_SCHED;
            PG8_LDB(B1, 1, 1); PG8_STAGE(PG8_SB(1, 0), b3, voffB);
            PG8_BAR; PG8_WAIT_L(0); PG8_MMA(0, 1, At, B1); PG8_BAR;
            PG8_LDA(At, 1, 1); PG8_STAGE(PG8_SA(1, 0), a3, voffA);
            PG8_BAR; PG8_WAIT_L(0); PG8_MMA(1, 0, At, B0); PG8_BAR; PG8_SCHED;
            PG8_STAGE(PG8_SB(1, 1), b3 + hstep, voffB);
            PG8_WAIT_V(6); PG8_BAR; PG8_MMA(1, 1, At, B1); PG8_BAR;
            }
        }
        if constexpr (ALIGN_EPI) { if (wr == 0) PG8_BAR; }
        if constexpr (!Epi::AFTER_DRAIN) { E(acc, cur, wr, wc, fr, fq); S.done(cur); }
        if (!has_next) break;
#pragma unroll
        for (int a = 0; a < 2; ++a)
#pragma unroll
            for (int b = 0; b < 2; ++b)
#pragma unroll
                for (int m = 0; m < 4; ++m)
#pragma unroll
                    for (int n = 0; n < 2; ++n) acc[a][b][m][n] = (f32x4){0.f, 0.f, 0.f, 0.f};
        cur = nxt; cA = nA; cB = nB; ++ui;
        if constexpr (ALIGN_EPI) { if (wr == 1) PG8_BAR; }
    }
    PG8_WAIT_V(0);
    if constexpr (!ALIGN_EPI) { if (wr == 0) PG8_BAR; }
    PG8_BAR;
    if constexpr (Epi::AFTER_DRAIN) { E.fused(acc, cur, wr, wc, fr, fq, lds, wid, lane); S.done(cur); }
#undef PG8_SA
#undef PG8_SB
#undef PG8_STAGE
#undef PG8_LDA
#undef PG8_LDB
#undef PG8_MMA
#undef PG8_WAIT_V
#undef PG8_WAIT_L
#undef PG8_BAR
#undef PG8_SCHED
}
}

#define LAS __attribute__((address_space(3)))
typedef unsigned short bf16;
typedef pg8::f32x4 f32x4;
typedef pg8::bf16x8 bf16x8;
typedef pg8::u32x4 u32x4;
typedef unsigned u32x2 __attribute__((ext_vector_type(2)));
typedef float f32x2 __attribute__((ext_vector_type(2)));

constexpr int NWAVES = 8, NTHR = 512;
constexpr int DM = 1024, MPR = 16384, MV = 16512, MPAD = 16640, SEQ = 8192;
constexpr int AB_IN = 2304, DFF = 2816, SSM_INP = 5376, SSM_INV = 5152, XBCW = 3072, ZW = 2048;
constexpr float EPS = 1e-6f;
constexpr size_t MiB = 1u << 20;
constexpr size_t WS_ROPE = 0, WS_BAR = 512 * 1024, BAR_BYTES = 16384;
constexpr size_t WS_W_ABIN = 1 * MiB, WS_W_ABOUT = WS_W_ABIN + 9 * MiB / 2, WS_W_UP0 = WS_W_ABOUT + 2 * MiB, WS_W_DN0 = WS_W_UP0 + 11 * MiB;
constexpr size_t WS_HALO = 1 * MiB, WS_DT = 6 * MiB, WS_SEG = 9 * MiB, WS_SEGD = 16 * MiB;
constexpr size_t WS_W_SSMIN = 24 * MiB, WS_W_SSMOUT = WS_W_SSMIN + 21 * MiB / 2, WS_W_UP1 = WS_W_SSMOUT + 4 * MiB, WS_W_DN1 = WS_W_UP1 + 11 * MiB;
constexpr size_t WS_XN = 55 * MiB;
constexpr size_t WS_P0 = 88 * MiB, WS_CAT = 162 * MiB, WS_MIX = 195 * MiB, WS_H = 88 * MiB, WS_Z = 88 * MiB, WS_XBC = 153 * MiB, WS_END = 256 * MiB;
static_assert(WS_W_DN0 + (size_t)DM * DFF * 2 <= 24 * MiB && WS_W_DN1 + (size_t)DM * DFF * 2 <= WS_XN && WS_XN + (size_t)MPAD * DM * 2 <= WS_P0, "ws map 1");
static_assert(WS_P0 + (size_t)MPAD * AB_IN * 2 <= WS_CAT && WS_CAT + (size_t)MPAD * DM * 2 <= WS_MIX && WS_MIX + (size_t)MPAD * DM * 2 <= WS_END, "ws map 2");
static_assert(WS_H + (size_t)MPAD * DFF * 2 <= WS_MIX && WS_Z + (size_t)MPAD * ZW * 2 <= WS_XBC && WS_XBC + (size_t)MPAD * XBCW * 2 <= WS_END, "ws map 3");
static_assert(WS_HALO + (size_t)260 * 3 * XBCW * 2 <= WS_DT && WS_DT + (size_t)MPAD * 32 * 4 <= WS_SEG && WS_SEG + (size_t)192 * 8192 * 4 <= WS_SEGD, "ws map 4");
constexpr size_t O_Y = 0, O_KP = 16908288, O_VP = O_KP + 32768, O_SCP = O_VP + 32768, O_CCP = O_SCP + 2048, O_SSP = O_CCP + 18432, O_KS = O_SSP + 524288, O_VS = O_KS + 16384,
                 O_SCS = O_VS + 16384, O_CCS = O_SCS + 8192, O_SSS = O_CCS + 73728, O_END = O_SSS + 2097152;
static_assert(O_END == 19730432, "output size");
constexpr int LDS_BYTES = 147456;

struct Args { const float* in[23]; float* out; unsigned char* ws; int ph_lo, ph_hi; };
enum { I_XP = 0, I_XS, I_CK, I_CV, I_SCONV, I_SSMCONV, I_SSM, I_NG, I_ABIN, I_ABOUT, I_SINK, I_SCW, I_SSMIN, I_SSMCW, I_SSMCB, I_DTB, I_ALOG, I_SSMD, I_SSMNG, I_SSMOUT, I_FG, I_FU, I_FD };

#define LDS_WAIT() asm volatile("s_waitcnt lgkmcnt(0)" ::: "memory")
typedef __bf16 bf16x2_t __attribute__((ext_vector_type(2)));
__device__ __forceinline__ unsigned pk2(float lo, float hi) { const f32x2 v = {lo, hi}; const bf16x2_t b = __builtin_convertvector(v, bf16x2_t); return __builtin_bit_cast(unsigned, b); }
__device__ __forceinline__ unsigned short f2bf(float f) { return (unsigned short)(pk2(f, 0.f) & 0xffffu); }
__device__ __forceinline__ float bflo(unsigned w) { return __builtin_bit_cast(float, w << 16); }
__device__ __forceinline__ float bfhi(unsigned w) { return __builtin_bit_cast(float, w & 0xffff0000u); }
__device__ __forceinline__ float bf1(unsigned short h) { return __builtin_bit_cast(float, (unsigned)h << 16); }
__device__ __forceinline__ void unpack8(const u32x4 w, float (&f)[8]) { f[0] = bflo(w.x); f[1] = bfhi(w.x); f[2] = bflo(w.y); f[3] = bfhi(w.y); f[4] = bflo(w.z); f[5] = bfhi(w.z); f[6] = bflo(w.w); f[7] = bfhi(w.w); }
__device__ __forceinline__ u32x4 pack8(const float (&f)[8]) { u32x4 w; w.x = pk2(f[0], f[1]); w.y = pk2(f[2], f[3]); w.z = pk2(f[4], f[5]); w.w = pk2(f[6], f[7]); return w; }
__device__ __forceinline__ float wave_sum(float v) {
#pragma unroll
    for (int o = 1; o < 64; o <<= 1) v += __shfl_xor(v, o);
    return v;
}
__device__ __forceinline__ float silu(float v) { return v * __builtin_amdgcn_rcpf(1.0f + __expf(-v)); }
__device__ __forceinline__ f32x4 mfma16(bf16x8 a, bf16x8 b, f32x4 c) { return __builtin_amdgcn_mfma_f32_16x16x32_bf16(a, b, c, 0, 0, 0); }

__device__ __forceinline__ void transpose_item(const float* W, int K, int N, bf16* WT, int mode, LAS float* scr, int item, int lane) {
    const int nblk = N / 32, kb = item / nblk, nb = item % nblk, k0 = 64 * kb, n0 = 32 * nb;
    float wv_[32];
#pragma unroll
    for (int i = 0; i < 32; ++i) wv_[i] = W[(size_t)(k0 + 2 * i + (lane >> 5)) * N + n0 + (lane & 31)];
#pragma unroll
    for (int i = 0; i < 32; ++i) scr[(2 * i + (lane >> 5)) * 33 + (lane & 31)] = wv_[i];
    LDS_WAIT(); asm volatile("" ::: "memory");
    const int c = lane & 7;
#pragma unroll
    for (int j = 0; j < 4; ++j) { const int n = (lane >> 3) + 8 * j; const LAS float* s = scr + (8 * c) * 33 + n; const int cn = n0 + n;
        const int drow = (mode == 0) ? cn : (((cn >> 4) << 5) + (cn & 15) + (mode == 2 ? 16 : 0));
        u32x4 o; o.x = pk2(s[0 * 33], s[1 * 33]); o.y = pk2(s[2 * 33], s[3 * 33]); o.z = pk2(s[4 * 33], s[5 * 33]); o.w = pk2(s[6 * 33], s[7 * 33]);
        *(u32x4*)(WT + (size_t)drow * K + k0 + 8 * c) = o; }
    LDS_WAIT(); asm volatile("" ::: "memory");
}
__device__ __forceinline__ void p0_prologue(const Args& a, LAS unsigned char* lds, int G, int bid) {
    const int tid = threadIdx.x, lane = tid & 63, wave = tid >> 6;
    unsigned char* ws = a.ws;
    LAS float* scr = (LAS float*)(lds + wave * 16384);
    const int gw = bid * NWAVES + wave, NGW = G * NWAVES;
    constexpr int I_1 = 16 * 72, I_2 = 16 * 32, I_F = 16 * 88, I_D = 44 * 32, I_5 = 16 * 161, I_6 = 32 * 32;
    constexpr int NITEMS = I_1 + I_2 + 4 * I_F + 2 * I_D + I_5 + I_6;
    for (int it = gw; it < NITEMS; it += NGW) {
        int r = it;
        if (r < I_5) { transpose_item(a.in[I_SSMIN], DM, SSM_INV, (bf16*)(ws + WS_W_SSMIN), 0, scr, r, lane); continue; } r -= I_5;
        if (r < I_1) { transpose_item(a.in[I_ABIN], DM, AB_IN, (bf16*)(ws + WS_W_ABIN), 0, scr, r, lane); continue; } r -= I_1;
        if (r < I_2) { transpose_item(a.in[I_ABOUT], DM, DM, (bf16*)(ws + WS_W_ABOUT), 0, scr, r, lane); continue; } r -= I_2;
        if (r < I_F) { transpose_item(a.in[I_FG], DM, DFF, (bf16*)(ws + WS_W_UP0), 1, scr, r, lane); continue; } r -= I_F;
        if (r < I_F) { transpose_item(a.in[I_FU], DM, DFF, (bf16*)(ws + WS_W_UP0), 2, scr, r, lane); continue; } r -= I_F;
        if (r < I_D) { transpose_item(a.in[I_FD], DFF, DM, (bf16*)(ws + WS_W_DN0), 0, scr, r, lane); continue; } r -= I_D;
        if (r < I_6) { transpose_item(a.in[I_SSMOUT], ZW, DM, (bf16*)(ws + WS_W_SSMOUT), 0, scr, r, lane); continue; } r -= I_6;
        if (r < I_F) { transpose_item(a.in[I_FG] + (size_t)DM * DFF, DM, DFF, (bf16*)(ws + WS_W_UP1), 1, scr, r, lane); continue; } r -= I_F;
        if (r < I_F) { transpose_item(a.in[I_FU] + (size_t)DM * DFF, DM, DFF, (bf16*)(ws + WS_W_UP1), 2, scr, r, lane); continue; } r -= I_F;
        transpose_item(a.in[I_FD] + (size_t)DM * DFF, DFF, DM, (bf16*)(ws + WS_W_DN1), 0, scr, r, lane);
    }
    const int gt = bid * NTHR + tid, NGT = G * NTHR;
    { u32x4 z = (u32x4){0u, 0u, 0u, 0u};
      u32x4* p1 = (u32x4*)((bf16*)(ws + WS_W_SSMIN) + (size_t)SSM_INV * DM); for (int i = gt; i < (SSM_INP - SSM_INV) * DM / 8; i += NGT) p1[i] = z;
      u32x4* p2 = (u32x4*)((bf16*)(ws + WS_XN) + (size_t)MV * DM); for (int i = gt; i < (MPAD - MV) * DM / 8; i += NGT) p2[i] = z; }
    { f32x2* rope = (f32x2*)(ws + WS_ROPE);
      for (int i = gt; i < SEQ * 8; i += NGT) { const int pos = i >> 3, k = i & 7;
          const double invf = k == 0 ? 1.0 : k == 1 ? 0.19392274474868576 : k == 2 ? 0.03760603093086393 : k == 3 ? 0.007292664737217109 : k == 4 ? 0.001414213562373095 : k == 5 ? 0.0002742481756762073 : k == 6 ? 5.318295896944988e-05 : 1.031338537721246e-05;
          const double rev = (double)pos * invf * 0.15915494309189535; const float fr = (float)(rev - __builtin_floor(rev));
          rope[i] = (f32x2){__builtin_amdgcn_cosf(fr), __builtin_amdgcn_sinf(fr)}; } }
    const f32x4* g4 = (const f32x4*)(a.in[I_NG]);
    for (int row = gw; row < MV; row += NGW) {
        const f32x4* src = (const f32x4*)(row < MPR ? a.in[I_XP] + (size_t)row * DM : a.in[I_XS] + (size_t)(row - MPR) * DM);
        f32x4 v[4]; float ss = 0.f;
#pragma unroll
        for (int j = 0; j < 4; ++j) { v[j] = src[lane + 64 * j]; ss += (v[j].x * v[j].x + v[j].y * v[j].y) + (v[j].z * v[j].z + v[j].w * v[j].w); }
        const float r = __builtin_amdgcn_rsqf(wave_sum(ss) * (1.f / DM) + EPS);
        u32x2* o = (u32x2*)((bf16*)(ws + WS_XN) + (size_t)row * DM);
#pragma unroll
        for (int j = 0; j < 4; ++j) { const f32x4 g = g4[lane + 64 * j]; u32x2 w; w.x = pk2(v[j].x * r * g.x, v[j].y * r * g.y); w.y = pk2(v[j].z * r * g.z, v[j].w * r * g.w); o[lane + 64 * j] = w; }
    }
}
constexpr size_t XR_BYTE_OFF = (size_t)MV * DM * 2;
template <bool FIRST>
__device__ __forceinline__ void nrn_mid(const Args& a, const float* g1, const float* g2, int G, int bid) {
    const int tid = threadIdx.x, lane = tid & 63, wave = tid >> 6;
    const int gw = bid * NWAVES + wave, NGW = G * NWAVES;
    const bf16* mix = (const bf16*)(a.ws + WS_MIX); bf16* xn = (bf16*)(a.ws + WS_XN); bf16* xr = (bf16*)((unsigned char*)a.out + XR_BYTE_OFF);
    const f32x4* g14 = (const f32x4*)g1; const f32x4* g24 = (const f32x4*)g2;
    for (int row = gw; row < MV; row += NGW) {
        const u32x2* mp = (const u32x2*)(mix + (size_t)row * DM);
        u32x2* xrp = (u32x2*)(xr + (size_t)row * DM);
        const f32x4* xs = (const f32x4*)(row < MPR ? a.in[I_XP] + (size_t)row * DM : a.in[I_XS] + (size_t)(row - MPR) * DM);
        f32x4 m[4], xv[4]; float ss = 0.f;
#pragma unroll
        for (int j = 0; j < 4; ++j) { const u32x2 w = mp[lane + 64 * j]; m[j] = (f32x4){bflo(w.x), bfhi(w.x), bflo(w.y), bfhi(w.y)};
            if (FIRST) xv[j] = xs[lane + 64 * j]; else { const u32x2 xw = xrp[lane + 64 * j]; xv[j] = (f32x4){bflo(xw.x), bfhi(xw.x), bflo(xw.y), bfhi(xw.y)}; }
            ss += (m[j].x * m[j].x + m[j].y * m[j].y) + (m[j].z * m[j].z + m[j].w * m[j].w); }
        const float r1 = __builtin_amdgcn_rsqf(wave_sum(ss) * (1.f / DM) + EPS);
        float s2 = 0.f;
#pragma unroll
        for (int j = 0; j < 4; ++j) { const f32x4 g = g14[lane + 64 * j]; xv[j] = xv[j] + m[j] * r1 * g; u32x2 w; w.x = pk2(xv[j].x, xv[j].y); w.y = pk2(xv[j].z, xv[j].w); xrp[lane + 64 * j] = w;
            s2 += (xv[j].x * xv[j].x + xv[j].y * xv[j].y) + (xv[j].z * xv[j].z + xv[j].w * xv[j].w); }
        const float r2 = __builtin_amdgcn_rsqf(wave_sum(s2) * (1.f / DM) + EPS);
        u32x2* o = (u32x2*)(xn + (size_t)row * DM);
#pragma unroll
        for (int j = 0; j < 4; ++j) { const f32x4 g = g24[lane + 64 * j]; u32x2 w; w.x = pk2(xv[j].x * r2 * g.x, xv[j].y * r2 * g.y); w.y = pk2(xv[j].z * r2 * g.z, xv[j].w * r2 * g.w); o[lane + 64 * j] = w; }
    }
}
typedef short v4i16_t __attribute__((ext_vector_type(4)));
__device__ __forceinline__ u32x2 trd(const LAS bf16* X, int ST, int r0, int c0, int lane) {
    const int q = (lane & 15) >> 2, p = lane & 3;
    return __builtin_bit_cast(u32x2, __builtin_amdgcn_ds_read_tr16_b64_v4i16((LAS v4i16_t*)(X + (r0 + q) * ST + c0 + 4 * p)));
}
__device__ __forceinline__ bf16x8 trfrag(const LAS bf16* X, int ST, int kb, int c0, int lane) {
    const int fq = lane >> 4; const u32x2 lo = trd(X, ST, kb + 8 * fq, c0, lane), hi = trd(X, ST, kb + 8 * fq + 4, c0, lane);
    const u32x4 t = (u32x4){lo.x, lo.y, hi.x, hi.y}; return __builtin_bit_cast(bf16x8, t);
}
__device__ __forceinline__ void load8_rope(const bf16* hp, int dg, const f32x2* rp, float (&o)[8]) {
    const u32x4 w = *(const u32x4*)(hp + dg * 8); unpack8(w, o);
    if (dg < 2) { float p[8]; const u32x4 w2 = *(const u32x4*)(hp + (1 - dg) * 8); unpack8(w2, p);
#pragma unroll
        for (int j = 0; j < 8; ++j) { const f32x2 cs = rp[j]; o[j] = dg == 0 ? o[j] * cs.x - p[j] * cs.y : o[j] * cs.x + p[j] * cs.y; } }
}
__device__ __forceinline__ void attn_phase(const Args& a, LAS unsigned char* lds, int G, int bid) {
    LAS bf16* Qs = (LAS bf16*)lds;
    LAS bf16* Ks = (LAS bf16*)(lds + 36864);
    LAS bf16* Vs = (LAS bf16*)(lds + 64512);
    const int tid = threadIdx.x, lane = tid & 63, w = tid >> 6, fr = lane & 15, fq = lane >> 4;
    const bf16* P0 = (const bf16*)(a.ws + WS_P0); bf16* CAT = (bf16*)(a.ws + WS_CAT);
    const f32x2* rope = (const f32x2*)(a.ws + WS_ROPE);
    for (int u = bid; u < 528; u += G) {
        const bool smp = u >= 512;
        int b, c = 0, kvh, nq, nkc = 0, nvalid, qrow0;
        if (!smp) { kvh = u & 1; c = (u >> 1) & 127; b = u >> 8; nq = 64; nkc = (c < 2 ? c : 2) + 1; nvalid = 64 * nkc; qrow0 = b * SEQ + c * 64; }
        else { const int v = u - 512; kvh = v & 1; b = v >> 1; nq = 16; nvalid = 144; qrow0 = MPR + b * 16; }
#pragma unroll
        for (int it = 0; it < 4; ++it) { const int item = tid + NTHR * it, q = item >> 3, dg = item & 7, hh = q >> 6, i = q & 63;
            u32x4 o = (u32x4){0u, 0u, 0u, 0u};
            if (i < nq) { const int pos = smp ? 4096 + i : c * 64 + i; float f[8]; load8_rope(P0 + (size_t)(qrow0 + i) * AB_IN + (4 * kvh + hh) * 64, dg, rope + pos * 8, f);
#pragma unroll
                for (int j = 0; j < 8; ++j) f[j] *= 0.125f;
                o = pack8(f); }
            *(LAS u32x4*)(Qs + q * 72 + dg * 8) = o; }
#pragma unroll
        for (int it = 0; it < 3; ++it) { const int item = tid + NTHR * it, kr = item >> 3, dg = item & 7;
            u32x4 ko = (u32x4){0u, 0u, 0u, 0u}, vo = ko;
            if (kr < nvalid) {
                if (smp && kr < 128) { const size_t off = ((size_t)(b * 128 + kr) * 2 + kvh) * 64 + dg * 8;
                    const f32x4 k0 = *(const f32x4*)(a.in[I_CK] + off), k1 = *(const f32x4*)(a.in[I_CK] + off + 4), v0 = *(const f32x4*)(a.in[I_CV] + off), v1 = *(const f32x4*)(a.in[I_CV] + off + 4);
                    ko.x = pk2(k0.x, k0.y); ko.y = pk2(k0.z, k0.w); ko.z = pk2(k1.x, k1.y); ko.w = pk2(k1.z, k1.w); vo.x = pk2(v0.x, v0.y); vo.y = pk2(v0.z, v0.w); vo.z = pk2(v1.x, v1.y); vo.w = pk2(v1.z, v1.w); }
                else { int row, pos; if (smp) { row = MPR + b * 16 + (kr - 128); pos = 4096 + kr - 128; } else { pos = (c - nkc + 1 + (kr >> 6)) * 64 + (kr & 63); row = b * SEQ + pos; }
                    const bf16* rp = P0 + (size_t)row * AB_IN; float f[8]; load8_rope(rp + 512 + kvh * 64, dg, rope + pos * 8, f); ko = pack8(f);
                    vo = *(const u32x4*)(rp + 640 + kvh * 64 + dg * 8); }
            }
            *(LAS u32x4*)(Ks + kr * 72 + dg * 8) = ko;
            *(LAS u32x4*)(Vs + kr * 72 + dg * 8) = vo; }
        __syncthreads();
        const int hh = w >> 1, qh = w & 1;
        if (qh * 32 < nq) {
            f32x4 s[12][2];
#pragma unroll
            for (int kt = 0; kt < 12; ++kt) { s[kt][0] = (f32x4){0.f, 0.f, 0.f, 0.f}; s[kt][1] = s[kt][0]; }
#pragma unroll
            for (int ks = 0; ks < 2; ++ks) {
                bf16x8 bq[2];
#pragma unroll
                for (int qt = 0; qt < 2; ++qt) bq[qt] = *(const LAS bf16x8*)(Qs + (w * 32 + qt * 16 + fr) * 72 + ks * 32 + fq * 8);
#pragma unroll
                for (int kt = 0; kt < 12; ++kt) if (kt * 16 < nvalid) { const bf16x8 ak = *(const LAS bf16x8*)(Ks + (kt * 16 + fr) * 72 + ks * 32 + fq * 8);
                    s[kt][0] = mfma16(ak, bq[0], s[kt][0]); s[kt][1] = mfma16(ak, bq[1], s[kt][1]); }
            }
            const float sink = a.in[I_SINK][4 * kvh + hh];
            float inv[2];
#pragma unroll
            for (int qt = 0; qt < 2; ++qt) {
                float m = sink;
#pragma unroll
                for (int kt = 0; kt < 12; ++kt) if (kt * 16 < nvalid) m = fmaxf(fmaxf(m, fmaxf(s[kt][qt][0], s[kt][qt][1])), fmaxf(s[kt][qt][2], s[kt][qt][3]));
                m = fmaxf(m, __shfl_xor(m, 16)); m = fmaxf(m, __shfl_xor(m, 32));
                float sum = 0.f;
#pragma unroll
                for (int kt = 0; kt < 12; ++kt) { if (kt * 16 < nvalid) {
#pragma unroll
                        for (int i = 0; i < 4; ++i) { const float p = __expf(s[kt][qt][i] - m); s[kt][qt][i] = p; sum += p; } }
                    else s[kt][qt] = (f32x4){0.f, 0.f, 0.f, 0.f}; }
                sum += __shfl_xor(sum, 16); sum += __shfl_xor(sum, 32);
                inv[qt] = 1.0f / (sum + __expf(sink - m));
            }
            f32x4 o[4][2];
#pragma unroll
            for (int dt = 0; dt < 4; ++dt) { o[dt][0] = (f32x4){0.f, 0.f, 0.f, 0.f}; o[dt][1] = o[dt][0]; }
#pragma unroll
            for (int kk = 0; kk < 6; ++kk) if (kk * 32 < nvalid) {
                bf16x8 bp[2];
#pragma unroll
                for (int qt = 0; qt < 2; ++qt) { u32x4 t; t.x = pk2(s[2 * kk][qt][0], s[2 * kk][qt][1]); t.y = pk2(s[2 * kk][qt][2], s[2 * kk][qt][3]); t.z = pk2(s[2 * kk + 1][qt][0], s[2 * kk + 1][qt][1]); t.w = pk2(s[2 * kk + 1][qt][2], s[2 * kk + 1][qt][3]);
                    bp[qt] = __builtin_bit_cast(bf16x8, t); }
#pragma unroll
                for (int dt = 0; dt < 4; ++dt) { const u32x2 lo = trd(Vs, 72, kk * 32 + 4 * fq, dt * 16, lane), hi = trd(Vs, 72, kk * 32 + 16 + 4 * fq, dt * 16, lane);
                    const u32x4 t = (u32x4){lo.x, lo.y, hi.x, hi.y}; const bf16x8 av = __builtin_bit_cast(bf16x8, t);
                    o[dt][0] = mfma16(av, bp[0], o[dt][0]); o[dt][1] = mfma16(av, bp[1], o[dt][1]); }
            }
#pragma unroll
            for (int qt = 0; qt < 2; ++qt) { const int tok = qh * 32 + qt * 16 + fr;
                if (tok < nq) { bf16* op = CAT + (size_t)(qrow0 + tok) * DM + (4 * kvh + hh) * 64 + 4 * fq;
#pragma unroll
                    for (int dt = 0; dt < 4; ++dt) { const f32x4 v = o[dt][qt] * inv[qt]; u32x2 wv; wv.x = pk2(v[0], v[1]); wv.y = pk2(v[2], v[3]); *(u32x2*)(op + dt * 16) = wv; } } }
        }
        __syncthreads();
    }
    const int gt = bid * NTHR + tid, NGT = G * NTHR;
    const float* scw = a.in[I_SCW];
    const int nx3 = G >= 64 ? 528 - 2 * G : 0, cvw = (nx3 > 0 && nx3 < G) ? nx3 : 0;
    for (int it = bid >= cvw ? (bid - cvw) * NTHR + tid : MV * 64; it < MV * 64; it += (G - cvw) * NTHR) { const int row = it >> 6, ch = (it & 63) * 8;
        int t, L, bb; if (row < MPR) { bb = row >> 13; t = row & (SEQ - 1); L = SEQ; } else { bb = (row - MPR) >> 4; t = (row - MPR) & 15; L = 16; }
        float acc[8], uc[8];
#pragma unroll
        for (int j = 0; j < 8; ++j) acc[j] = 0.f;
#pragma unroll
        for (int d = 0; d < 3; ++d) {
            const int tt = t - 2 + d; float uu[8];
            if (tt >= 0) { const bf16* rp = P0 + (size_t)(row - 2 + d) * AB_IN; float gc[8], hx[8]; unpack8(*(const u32x4*)(rp + 1280 + ch), gc); unpack8(*(const u32x4*)(rp + 1792 + ch), hx);
#pragma unroll
                for (int j = 0; j < 8; ++j) uu[j] = gc[j] * hx[j]; }
            else if (row >= MPR) { const float* hp = a.in[I_SCONV] + ((size_t)bb * 2 + (2 + tt)) * 512 + ch;
#pragma unroll
                for (int j = 0; j < 8; ++j) uu[j] = hp[j]; }
            else {
#pragma unroll
                for (int j = 0; j < 8; ++j) uu[j] = 0.f; }
#pragma unroll
            for (int j = 0; j < 8; ++j) { acc[j] += scw[d * 512 + ch + j] * uu[j]; if (d == 2) uc[j] = uu[j]; }
        }
        float gb[8]; unpack8(*(const u32x4*)(P0 + (size_t)row * AB_IN + 768 + ch), gb);
#pragma unroll
        for (int j = 0; j < 8; ++j) acc[j] *= gb[j];
        *(u32x4*)(CAT + (size_t)row * DM + 512 + ch) = pack8(acc);
        if (t >= L - 2) { float* op = a.out + (row < MPR ? O_SCP + ((size_t)bb * 2 + (t - (L - 2))) * 512 : O_SCS + ((size_t)bb * 2 + (t - (L - 2))) * 512) + ch;
#pragma unroll
            for (int j = 0; j < 8; ++j) op[j] = uc[j]; }
    }
    for (int it = gt; it < (256 + 128) * 32; it += NGT) { const int ri = it >> 5, kvh = (it >> 4) & 1, dg = (it >> 1) & 7, isv = it & 1;
        int row, pos; float* op;
        if (ri < 256) { const int bb = ri >> 7, j = ri & 127; pos = SEQ - 128 + j; row = bb * SEQ + pos; op = a.out + (isv ? O_VP : O_KP) + ((size_t)(bb * 128 + j) * 2 + kvh) * 64 + dg * 8; }
        else { const int r2 = ri - 256, bb = r2 >> 4, j = r2 & 15; pos = 4096 + j; row = MPR + r2; op = a.out + (isv ? O_VS : O_KS) + ((size_t)(bb * 16 + j) * 2 + kvh) * 64 + dg * 8; }
        const bf16* rp = P0 + (size_t)row * AB_IN; float f[8];
        if (isv) unpack8(*(const u32x4*)(rp + 640 + kvh * 64 + dg * 8), f); else load8_rope(rp + 512 + kvh * 64, dg, rope + pos * 8, f);
        *(f32x4*)op = (f32x4){f[0], f[1], f[2], f[3]}; *(f32x4*)(op + 4) = (f32x4){f[4], f[5], f[6], f[7]};
    }
}

__device__ __forceinline__ void conv16(bf16* p, const float (&w0)[8], const float (&w1)[8], const float (&w2)[8], const float (&w3)[8], const float (&bz)[8], float (&h0)[8], float (&h1)[8], float (&h2)[8]) {
#pragma unroll
    for (int r = 0; r < 16; r += 8) {
        u32x4 raw[8];
#pragma unroll
        for (int q = 0; q < 8; ++q) raw[q] = *(const u32x4*)(p + (size_t)(r + q) * XBCW);
#pragma unroll
        for (int q = 0; q < 8; ++q) { float cur[8], y[8]; unpack8(raw[q], cur);
#pragma unroll
            for (int j = 0; j < 8; ++j) { y[j] = silu(w0[j] * h0[j] + w1[j] * h1[j] + w2[j] * h2[j] + w3[j] * cur[j] + bz[j]); h0[j] = h1[j]; h1[j] = h2[j]; h2[j] = cur[j]; }
            *(u32x4*)(p + (size_t)(r + q) * XBCW) = pack8(y); }
    }
}
__device__ __forceinline__ void ssmconv_phase(const Args& a, int G, int bid) {
    const int tid = threadIdx.x, gt = bid * NTHR + tid, NGT = G * NTHR;
    bf16* XBC = (bf16*)(a.ws + WS_XBC); const bf16* HALO = (const bf16*)(a.ws + WS_HALO);
    const float* cw = a.in[I_SSMCW]; const float* cb = a.in[I_SSMCB];
    for (int base = bid * NTHR; base < 256 * 384 * 4; base += G * NTHR) {
        const int it = base + tid, qtr = it & 3, q = it >> 2, blk = q / 384, col = (q - blk * 384) * 8, r0 = blk * 64 + qtr * 16;
        float h0[8], h1[8], h2[8], w0[8], w1[8], w2[8], w3[8], bz[8];
#pragma unroll
        for (int j = 0; j < 8; ++j) { h0[j] = 0.f; h1[j] = 0.f; h2[j] = 0.f; w0[j] = cw[col + j]; w1[j] = cw[XBCW + col + j]; w2[j] = cw[2 * XBCW + col + j]; w3[j] = cw[3 * XBCW + col + j]; bz[j] = cb[col + j]; }
        bf16* p = XBC + (size_t)r0 * XBCW + col;
        if (qtr) { unpack8(*(const u32x4*)(p - 3 * XBCW), h0); unpack8(*(const u32x4*)(p - 2 * XBCW), h1); unpack8(*(const u32x4*)(p - XBCW), h2); }
        else if (blk & 127) { const bf16* hal = HALO + (size_t)(blk - 1) * 3 * XBCW + col; unpack8(*(const u32x4*)hal, h0); unpack8(*(const u32x4*)(hal + XBCW), h1); unpack8(*(const u32x4*)(hal + 2 * XBCW), h2); }
        asm volatile("s_waitcnt vmcnt(0)" ::: "memory");
        __syncthreads();
        conv16(p, w0, w1, w2, w3, bz, h0, h1, h2);
        if (qtr == 3 && (blk & 127) == 127) { float* outc = a.out + O_CCP + (size_t)(blk >> 7) * 3 * XBCW + col;
#pragma unroll
            for (int j = 0; j < 8; ++j) { outc[j] = h0[j]; outc[XBCW + j] = h1[j]; outc[2 * XBCW + j] = h2[j]; } }
    }
    for (int v = (tid < 12 ? bid * 12 + tid : 8 * 384); v < 8 * 384; v += G * 12) {
        const int bs = v / 384, col = (v - bs * 384) * 8;
        const float* hist = a.in[I_SSMCONV] + (size_t)bs * 3 * XBCW + col; float* outc = a.out + O_CCS + (size_t)bs * 3 * XBCW + col;
        float h0[8], h1[8], h2[8], w0[8], w1[8], w2[8], w3[8], bz[8];
#pragma unroll
        for (int j = 0; j < 8; ++j) { h0[j] = hist[j]; h1[j] = hist[XBCW + j]; h2[j] = hist[2 * XBCW + j]; w0[j] = cw[col + j]; w1[j] = cw[XBCW + col + j]; w2[j] = cw[2 * XBCW + col + j]; w3[j] = cw[3 * XBCW + col + j]; bz[j] = cb[col + j]; }
        conv16(XBC + (size_t)(MPR + bs * 16) * XBCW + col, w0, w1, w2, w3, bz, h0, h1, h2);
#pragma unroll
        for (int j = 0; j < 8; ++j) { outc[j] = h0[j]; outc[XBCW + j] = h1[j]; outc[2 * XBCW + j] = h2[j]; }
    }
    float* DT = (float*)(a.ws + WS_DT); const float* dtb = a.in[I_DTB];
    for (int it = gt; it < MV * 32; it += NGT) { const float x = DT[it] + dtb[it & 31]; const float e = __expf(x);
        DT[it] = x > 20.f ? x : (e < 1e-2f ? e * (1.f - e * (0.5f - e * 0.33333333f)) : __logf(1.f + e)); }
}

constexpr int S_XS = 0, S_XW = 9216, S_BM = 18432, S_CM = 35840, S_HA = 53248, S_SC = 70656;
template <bool FULL>
__device__ __forceinline__ void ssd_stream(const Args& a, LAS unsigned char* lds, f32x4 (&st)[2][2], const int row0, const int nchunks, const int nvalid, const int h, const float a_h, const float d_h, float& logdec) {
    LAS bf16* Xs = (LAS bf16*)(lds + S_XS); LAS bf16* Xw = (LAS bf16*)(lds + S_XW); LAS bf16* Bm = (LAS bf16*)(lds + S_BM);
    LAS bf16* Cm = (LAS bf16*)(lds + S_CM); LAS bf16* HA = (LAS bf16*)(lds + S_HA); LAS float* scal0 = (LAS float*)(lds + S_SC);
    const int tid = threadIdx.x, lane = tid & 63, w = tid >> 6, fr = lane & 15, fq = lane >> 4, nq4 = w & 3, pr = w >> 2, g = h >> 3, lt = w & 3;
    const bf16* XBC = (const bf16*)(a.ws + WS_XBC); bf16* Z = (bf16*)(a.ws + WS_Z); const float* DT = (const float*)(a.ws + WS_DT);
    u32x4 px, pb[2], pc[2]; float pdt = 0.f;
    const u32x4 zero4 = (u32x4){0u, 0u, 0u, 0u};
    const int xl = tid >> 3, xpg = tid & 7;
    const bool lv = lane < nvalid;
#define SSD_PREFETCH(ci) do { const int rb_ = row0 + 64 * (ci); \
        px = xl < nvalid ? *(const u32x4*)(XBC + (size_t)(rb_ + xl) * XBCW + h * 64 + xpg * 8) : zero4; \
        _Pragma("unroll") for (int k_ = 0; k_ < 2; ++k_) { const int item_ = tid + NTHR * k_, l_ = item_ >> 4, ng_ = item_ & 15; \
            pb[k_] = l_ < nvalid ? *(const u32x4*)(XBC + (size_t)(rb_ + l_) * XBCW + 2048 + g * 128 + ng_ * 8) : zero4; \
            if (FULL) pc[k_] = l_ < nvalid ? *(const u32x4*)(XBC + (size_t)(rb_ + l_) * XBCW + 2560 + g * 128 + ng_ * 8) : zero4; } } while (0)
#define SSD_DTLOAD(ci) do { pdt = (lv && (ci) < nchunks) ? DT[(size_t)(row0 + 64 * (ci) + lane) * 32 + h] : 0.f; } while (0)
#define SSD_SCAN(buf) do { LAS float* sc_ = scal0 + 320 * (buf); const float dtl_ = pdt; float v_ = dtl_ * a_h; \
        _Pragma("unroll") for (int o_ = 1; o_ < 64; o_ <<= 1) { const float t_ = __shfl_up(v_, o_); if (lane >= o_) v_ += t_; } \
        const float tot_ = __shfl(v_, 63); sc_[lane] = v_; sc_[64 + lane] = __expf(v_); sc_[128 + lane] = __expf(tot_ - v_) * dtl_; sc_[192 + lane] = dtl_; if (lane == 0) sc_[256] = tot_; } while (0)
    SSD_PREFETCH(0);
    if (w == 0) { SSD_DTLOAD(0); SSD_SCAN(0); SSD_DTLOAD(1); }
    __syncthreads();
    for (int ci = 0; ci < nchunks; ++ci) {
        const int rbase = row0 + 64 * ci;
        LAS float* scal = scal0 + 320 * (ci & 1);
        { const float dte = scal[128 + xl]; float f[8]; unpack8(px, f);
#pragma unroll
          for (int j = 0; j < 8; ++j) f[j] *= dte;
          *(LAS u32x4*)(Xw + xl * 72 + xpg * 8) = pack8(f);
          if (FULL) *(LAS u32x4*)(Xs + xl * 72 + xpg * 8) = px; }
#pragma unroll
        for (int k = 0; k < 2; ++k) { const int item = tid + NTHR * k, l = item >> 4, ng = item & 15;
            *(LAS u32x4*)(Bm + l * 136 + ng * 8) = pb[k];
            if (FULL) *(LAS u32x4*)(Cm + l * 136 + ng * 8) = pc[k]; }
        if (FULL) {
#pragma unroll
            for (int nt = 0; nt < 2; ++nt)
#pragma unroll
                for (int pt = 0; pt < 2; ++pt) { const f32x4 v = st[nt][pt]; u32x2 wv; wv.x = pk2(v[0], v[1]); wv.y = pk2(v[2], v[3]);
                    *(LAS u32x2*)(HA + (32 * pr + 16 * pt + fr) * 136 + 32 * nq4 + 16 * nt + 4 * fq) = wv; } }
        if (ci + 1 < nchunks) SSD_PREFETCH(ci + 1);
        __syncthreads();
        if (w == 0 && ci + 1 < nchunks) { SSD_SCAN((ci + 1) & 1); SSD_DTLOAD(ci + 2); }
        u32x2 zr[2]; const int l = 16 * lt + fr;
        if (FULL) {
#pragma unroll
            for (int k2 = 0; k2 < 2; ++k2) { zr[k2] = (u32x2){0u, 0u}; if (l < nvalid) zr[k2] = *(const u32x2*)(Z + (size_t)(rbase + l) * ZW + h * 64 + 16 * (2 * pr + k2) + 4 * fq); } }
        { const float tot = scal[256]; logdec += tot; const float dec = __expf(tot);
#pragma unroll
          for (int nt = 0; nt < 2; ++nt)
#pragma unroll
              for (int pt = 0; pt < 2; ++pt) st[nt][pt] = st[nt][pt] * dec;
#pragma unroll
          for (int ks = 0; ks < 2; ++ks) { bf16x8 af[2], bx[2];
#pragma unroll
              for (int t = 0; t < 2; ++t) { af[t] = trfrag(Bm, 136, 32 * ks, 32 * nq4 + 16 * t, lane); bx[t] = trfrag(Xw, 72, 32 * ks, 32 * pr + 16 * t, lane); }
#pragma unroll
              for (int nt = 0; nt < 2; ++nt)
#pragma unroll
                  for (int pt = 0; pt < 2; ++pt) st[nt][pt] = mfma16(af[nt], bx[pt], st[nt][pt]); } }
        if (FULL) {
            bf16x8 cf[4];
#pragma unroll
            for (int ks = 0; ks < 4; ++ks) cf[ks] = *(const LAS bf16x8*)(Cm + l * 136 + ks * 32 + fq * 8);
            const float al = scal[l];
            unsigned wpk[4][2];
#pragma unroll
            for (int s4 = 0; s4 < 4; ++s4) {
                wpk[s4][0] = 0u; wpk[s4][1] = 0u;
                if (s4 <= lt) { f32x4 acc = (f32x4){0.f, 0.f, 0.f, 0.f};
#pragma unroll
                    for (int ks = 0; ks < 4; ++ks) { const bf16x8 af = *(const LAS bf16x8*)(Bm + (16 * s4 + fr) * 136 + ks * 32 + fq * 8); acc = mfma16(af, cf[ks], acc); }
                    const f32x4 as = *(const LAS f32x4*)(scal + 16 * s4 + 4 * fq), ds = *(const LAS f32x4*)(scal + 192 + 16 * s4 + 4 * fq); float v[4];
#pragma unroll
                    for (int i = 0; i < 4; ++i) { const int s = 16 * s4 + 4 * fq + i; v[i] = s <= l ? acc[i] * __expf(al - as[i]) * ds[i] : 0.f; }
                    wpk[s4][0] = pk2(v[0], v[1]); wpk[s4][1] = pk2(v[2], v[3]); }
            }
            bf16x8 bw[2];
#pragma unroll
            for (int ks = 0; ks < 2; ++ks) { const u32x4 t = (u32x4){wpk[2 * ks][0], wpk[2 * ks][1], wpk[2 * ks + 1][0], wpk[2 * ks + 1][1]}; bw[ks] = __builtin_bit_cast(bf16x8, t); }
            const float e = scal[64 + l];
#pragma unroll
            for (int k2 = 0; k2 < 2; ++k2) { const int pt = 2 * pr + k2;
                f32x4 dg = (f32x4){0.f, 0.f, 0.f, 0.f}, of = dg;
#pragma unroll
                for (int ks = 0; ks < 2; ++ks) { const u32x2 lo = trd(Xs, 72, 32 * ks + 4 * fq, 16 * pt, lane), hi = trd(Xs, 72, 32 * ks + 16 + 4 * fq, 16 * pt, lane);
                    const u32x4 t = (u32x4){lo.x, lo.y, hi.x, hi.y}; dg = mfma16(__builtin_bit_cast(bf16x8, t), bw[ks], dg); }
#pragma unroll
                for (int ks = 0; ks < 4; ++ks) { const bf16x8 af = *(const LAS bf16x8*)(HA + (16 * pt + fr) * 136 + ks * 32 + fq * 8); of = mfma16(af, cf[ks], of); }
                const u32x2 xr = *(const LAS u32x2*)(Xs + l * 72 + 16 * pt + 4 * fq);
                const float zf[4] = {bflo(zr[k2].x), bfhi(zr[k2].x), bflo(zr[k2].y), bfhi(zr[k2].y)}, xf[4] = {bflo(xr.x), bfhi(xr.x), bflo(xr.y), bfhi(xr.y)}; float y[4];
#pragma unroll
                for (int i = 0; i < 4; ++i) y[i] = (dg[i] + of[i] * e + d_h * xf[i]) * silu(zf[i]);
                if (l < nvalid) { u32x2 wv; wv.x = pk2(y[0], y[1]); wv.y = pk2(y[2], y[3]); *(u32x2*)(Z + (size_t)(rbase + l) * ZW + h * 64 + 16 * pt + 4 * fq) = wv; } }
        }
        __syncthreads();
    }
#undef SSD_PREFETCH
#undef SSD_DTLOAD
#undef SSD_SCAN
}
__device__ __forceinline__ void ssd_pass_a(const Args& a, LAS unsigned char* lds, int G, int bid) {
    const int tid = threadIdx.x;
    float* SEG = (float*)(a.ws + WS_SEG); float* SEGD = (float*)(a.ws + WS_SEGD);
    for (int u = bid; u < 192; u += G) { const int bh = u / 3, seg = u - bh * 3, b = bh >> 5, h = bh & 31;
        f32x4 st[2][2];
#pragma unroll
        for (int i = 0; i < 2; ++i) { st[i][0] = (f32x4){0.f, 0.f, 0.f, 0.f}; st[i][1] = st[i][0]; }
        float logdec = 0.f; const float a_h = -__expf(a.in[I_ALOG][h]);
        ssd_stream<false>(a, lds, st, b * SEQ + seg * 2048, 32, 64, h, a_h, 0.f, logdec);
        f32x4* sp = (f32x4*)(SEG + (size_t)u * 8192);
#pragma unroll
        for (int i = 0; i < 2; ++i)
#pragma unroll
            for (int j = 0; j < 2; ++j) sp[(i * 2 + j) * NTHR + tid] = st[i][j];
        if (tid == 0) SEGD[u] = logdec;
    }
}
__device__ __forceinline__ void ssd_pass_b(const Args& a, LAS unsigned char* lds, int G, int bid) {
    const int tid = threadIdx.x, lane = tid & 63, w = tid >> 6, fr = lane & 15, fq = lane >> 4, nq4 = w & 3, pr = w >> 2;
    const float* SEG = (const float*)(a.ws + WS_SEG); const float* SEGD = (const float*)(a.ws + WS_SEGD);
    for (int u = bid; u < 512; u += G) {
        f32x4 st[2][2]; float logdec = 0.f;
        if (u < 256) { const int bh = u >> 2, seg = u & 3, b = bh >> 5, h = bh & 31;
#pragma unroll
            for (int i = 0; i < 2; ++i) { st[i][0] = (f32x4){0.f, 0.f, 0.f, 0.f}; st[i][1] = st[i][0]; }
            for (int s = 0; s < seg; ++s) { const float dec = __expf(SEGD[bh * 3 + s]); const f32x4* sp = (const f32x4*)(SEG + (size_t)(bh * 3 + s) * 8192);
#pragma unroll
                for (int i = 0; i < 2; ++i)
#pragma unroll
                    for (int j = 0; j < 2; ++j) st[i][j] = st[i][j] * dec + sp[(i * 2 + j) * NTHR + tid]; }
            const float a_h = -__expf(a.in[I_ALOG][h]), d_h = a.in[I_SSMD][h];
            ssd_stream<true>(a, lds, st, b * SEQ + seg * 2048, 32, 64, h, a_h, d_h, logdec);
            if (seg == 3) { float* op = a.out + O_SSP + (size_t)bh * 8192;
#pragma unroll
                for (int nt = 0; nt < 2; ++nt)
#pragma unroll
                    for (int pt = 0; pt < 2; ++pt) *(f32x4*)(op + (32 * pr + 16 * pt + fr) * 128 + 32 * nq4 + 16 * nt + 4 * fq) = st[nt][pt]; }
        } else { const int v = u - 256, bs = v >> 5, h = v & 31;
            const float* ip = a.in[I_SSM] + (size_t)v * 8192;
#pragma unroll
            for (int nt = 0; nt < 2; ++nt)
#pragma unroll
                for (int pt = 0; pt < 2; ++pt) st[nt][pt] = *(const f32x4*)(ip + (32 * pr + 16 * pt + fr) * 128 + 32 * nq4 + 16 * nt + 4 * fq);
            const float a_h = -__expf(a.in[I_ALOG][h]), d_h = a.in[I_SSMD][h];
            ssd_stream<true>(a, lds, st, MPR + bs * 16, 1, 16, h, a_h, d_h, logdec);
            float* op = a.out + O_SSS + (size_t)v * 8192;
#pragma unroll
            for (int nt = 0; nt < 2; ++nt)
#pragma unroll
                for (int pt = 0; pt < 2; ++pt) *(f32x4*)(op + (32 * pr + 16 * pt + fr) * 128 + 32 * nq4 + 16 * nt + 4 * fq) = st[nt][pt];
        }
    }
}
__device__ __forceinline__ void gnorm_phase(const Args& a, int G, int bid) {
    const int tid = threadIdx.x, lane = tid & 63, wave = tid >> 6, gw = bid * NWAVES + wave, NGW = G * NWAVES;
    bf16* Z = (bf16*)(a.ws + WS_Z); const float* ng = a.in[I_SSMNG];
    f32x4 g0[4], g1[4];
#pragma unroll
    for (int g = 0; g < 4; ++g) { g0[g] = *(const f32x4*)(ng + g * 512 + lane * 8); g1[g] = *(const f32x4*)(ng + g * 512 + lane * 8 + 4); }
    for (int row = gw; row < MV; row += NGW) {
        u32x4* p = (u32x4*)(Z + (size_t)row * ZW + lane * 8); u32x4 raw[4];
#pragma unroll
        for (int g = 0; g < 4; ++g) raw[g] = p[g * 64];
#pragma unroll
        for (int g = 0; g < 4; ++g) { float f[8]; unpack8(raw[g], f); float ss = 0.f;
#pragma unroll
            for (int j = 0; j < 8; ++j) ss += f[j] * f[j];
            const float r = __builtin_amdgcn_rsqf(wave_sum(ss) * (1.f / 512.f) + EPS);
            f[0] *= r * g0[g].x; f[1] *= r * g0[g].y; f[2] *= r * g0[g].z; f[3] *= r * g0[g].w; f[4] *= r * g1[g].x; f[5] *= r * g1[g].y; f[6] *= r * g1[g].z; f[7] *= r * g1[g].w;
            p[g * 64] = pack8(f); }
    }
}

__device__ __forceinline__ void sample_gemm(const bf16* A, const bf16* Bt, int K, bf16* out, LAS unsigned char* lds, int bid) {
    if (bid >= 64) return;
    const int tid = threadIdx.x, lane = tid & 63, w = tid >> 6, fr = lane & 15, fq = lane >> 4;
    const int row0 = MPR + 32 * (bid & 3), col0 = 64 * (bid >> 2), ksl = K >> 3, nst = ksl >> 5;
    const bf16* ap = A + (size_t)(row0 + fr) * K + w * ksl + 8 * fq;
    const bf16* bp = Bt + (size_t)(col0 + fr) * K + w * ksl + 8 * fq;
    f32x4 acc[2][4];
#pragma unroll
    for (int t = 0; t < 2; ++t)
#pragma unroll
        for (int c = 0; c < 4; ++c) acc[t][c] = (f32x4){0.f, 0.f, 0.f, 0.f};
    for (int s0 = 0; s0 < nst; s0 += 4) {
        bf16x8 af[4][2], bfm[4][4];
#pragma unroll
        for (int s = 0; s < 4; ++s) if (s0 + s < nst) {
#pragma unroll
            for (int t = 0; t < 2; ++t) af[s][t] = *(const bf16x8*)(ap + (size_t)(16 * t) * K + 32 * (s0 + s));
#pragma unroll
            for (int c = 0; c < 4; ++c) bfm[s][c] = *(const bf16x8*)(bp + (size_t)(16 * c) * K + 32 * (s0 + s)); }
#pragma unroll
        for (int s = 0; s < 4; ++s) if (s0 + s < nst) {
#pragma unroll
            for (int t = 0; t < 2; ++t)
#pragma unroll
                for (int c = 0; c < 4; ++c) acc[t][c] = mfma16(bfm[s][c], af[s][t], acc[t][c]); }
    }
    LAS f32x4* red = (LAS f32x4*)lds;
#pragma unroll
    for (int t = 0; t < 2; ++t)
#pragma unroll
        for (int c = 0; c < 4; ++c) red[(w * 8 + t * 4 + c) * 64 + lane] = acc[t][c];
    __syncthreads();
    f32x4 sum = red[w * 64 + lane];
#pragma unroll
    for (int v = 1; v < 8; ++v) sum = sum + red[(v * 8 + w) * 64 + lane];
    u32x2 wv; wv.x = pk2(sum[0], sum[1]); wv.y = pk2(sum[2], sum[3]);
    *(u32x2*)(out + (size_t)(row0 + 16 * (w >> 2) + fr) * DM + col0 + 16 * (w & 3) + 4 * fq) = wv;
    __syncthreads();
}

#define XB_TMO      128
#define XB_XCNT(j)  (256  + 64 * (j))
#define XB_XSUB(j)  (1280 + 64 * (j))
#define XB_XGEN(j)  (2304 + 64 * (j))
#define XB_TOP      3328
#define XB_TOPGEN   3392
#define XCD_BAR_WORDS 3456
#define XB_SPIN_CAP (1u << 18)

__device__ __forceinline__ unsigned xb_ld(unsigned* p)              { return __hip_atomic_load(p, __ATOMIC_RELAXED, __HIP_MEMORY_SCOPE_AGENT); }
__device__ __forceinline__ unsigned xb_add(unsigned* p, unsigned v) { return __hip_atomic_fetch_add(p, v, __ATOMIC_RELAXED, __HIP_MEMORY_SCOPE_AGENT); }
__device__ __forceinline__ unsigned xb_xcc_id() { return (unsigned)__builtin_amdgcn_s_getreg((3 << 11) | 20) & 0xFu; }
#define XB_SPIN(cond, bar) do { unsigned _sp = 0; while (cond) { __builtin_amdgcn_s_sleep(1); \
    if ((++_sp & 255u) == 0u) { if (xb_ld(&(bar)[XB_TMO])) break; if (_sp > XB_SPIN_CAP) { atomicAdd(&(bar)[XB_TMO], 1u); break; } } } } while (0)

struct XcdBarrier {
    unsigned* bar; unsigned x;
    volatile LAS unsigned* st;
};

__device__ __forceinline__ XcdBarrier xcd_barrier_post(unsigned* bar, volatile LAS unsigned* st) {
    XcdBarrier b; b.bar = bar; b.x = xb_xcc_id(); b.st = st;
    if (threadIdx.x == 0) (void)xb_add(&bar[XB_XCNT(b.x)], 1u);
    return b;
}
__device__ __forceinline__ void xcd_barrier_complete(unsigned* bar, unsigned x, unsigned& nloc, unsigned& nx) {
    const unsigned G = gridDim.x * gridDim.y * gridDim.z;
    unsigned sum, cnt, mine, sp = 0u;
    for (;;) {
        sum = 0u; cnt = 0u; mine = 0u;
#pragma unroll
        for (unsigned j = 0; j < 16; ++j) { const unsigned c = xb_ld(&bar[XB_XCNT(j)]); sum += c; cnt += (c > 0u) ? 1u : 0u; mine = (j == x) ? c : mine; }
        if (sum == G) break;
        __builtin_amdgcn_s_sleep(1);
        if ((++sp & 255u) == 0u) { if (xb_ld(&bar[XB_TMO])) break; if (sp > XB_SPIN_CAP) { atomicAdd(&bar[XB_TMO], 1u); break; } }
    }
    nloc = mine > 0u ? mine : 1u; nx = cnt > 0u ? cnt : 1u;
}

__device__ __forceinline__ void xcd_barrier(const XcdBarrier& b) {
    asm volatile("s_waitcnt vmcnt(0)" ::: "memory");
    __syncthreads();
    if (threadIdx.x == 0) {
        unsigned* bar = b.bar;
        __builtin_amdgcn_s_waitcnt(0);
        unsigned nloc = b.st[0], nx = b.st[1];
        if (nloc == 0u) { xcd_barrier_complete(bar, b.x, nloc, nx); b.st[0] = nloc; b.st[1] = nx; }
        const unsigned old = xb_add(&bar[XB_XSUB(b.x)], 1u);
        const unsigned gen = old / nloc;
        if (old + 1u == (gen + 1u) * nloc) {
            __builtin_amdgcn_fence(__ATOMIC_RELEASE, "agent");
            asm volatile("s_waitcnt vmcnt(0)" ::: "memory");
            const unsigned og = xb_add(&bar[XB_TOP], 1u);
            const unsigned tg = og / nx;
            if (og + 1u == (tg + 1u) * nx) xb_add(&bar[XB_TOPGEN], 1u);
            else XB_SPIN(xb_ld(&bar[XB_TOPGEN]) == tg, bar);
            __builtin_amdgcn_fence(__ATOMIC_ACQUIRE, "agent");
            xb_add(&bar[XB_XGEN(b.x)], 1u);
            asm volatile("s_waitcnt vmcnt(0)" ::: "memory");
        } else {
            XB_SPIN(xb_ld(&bar[XB_XGEN(b.x)]) == gen, bar);
            __builtin_amdgcn_fence(__ATOMIC_ACQUIRE, "agent");
            asm volatile("s_waitcnt vmcnt(0)" ::: "memory");
        }
    }
    __syncthreads();
}


__device__ __forceinline__ void nrn_final(const Args& a, const float* g1, int G, int bid, const XcdBarrier& bar) {
    const int tid = threadIdx.x, lane = tid & 63, wave = tid >> 6;
    const int gw = bid * NWAVES + wave, NGW = G * NWAVES;
    const bf16* mix = (const bf16*)(a.ws + WS_MIX); const bf16* xr = (const bf16*)((const unsigned char*)a.out + XR_BYTE_OFF);
    const f32x4* g14 = (const f32x4*)g1;
    constexpr int NIT = 9;
    u32x2 xw[NIT][4];
#pragma unroll
    for (int k = 0; k < NIT; ++k) { const int row = gw + k * NGW;
#pragma unroll
        for (int j = 0; j < 4; ++j) xw[k][j] = row < MV ? ((const u32x2*)(xr + (size_t)row * DM))[lane + 64 * j] : (u32x2){0u, 0u}; }
    xcd_barrier(bar);
#pragma unroll
    for (int k = 0; k < NIT; ++k) { const int row = gw + k * NGW;
        if (row < MV) {
            const u32x2* mp = (const u32x2*)(mix + (size_t)row * DM); f32x4* yp = (f32x4*)(a.out + (size_t)row * DM);
            f32x4 m[4]; float ss = 0.f;
#pragma unroll
            for (int j = 0; j < 4; ++j) { const u32x2 w = mp[lane + 64 * j]; m[j] = (f32x4){bflo(w.x), bfhi(w.x), bflo(w.y), bfhi(w.y)}; ss += (m[j].x * m[j].x + m[j].y * m[j].y) + (m[j].z * m[j].z + m[j].w * m[j].w); }
            const float r1 = __builtin_amdgcn_rsqf(wave_sum(ss) * (1.f / DM) + EPS);
#pragma unroll
            for (int j = 0; j < 4; ++j) { const f32x4 g = g14[lane + 64 * j]; const f32x4 xv = (f32x4){bflo(xw[k][j].x), bfhi(xw[k][j].x), bflo(xw[k][j].y), bfhi(xw[k][j].y)}; yp[lane + 64 * j] = xv + m[j] * r1 * g; }
        } }
}

#ifndef MK_ONE_LAUNCH
#define MK_ONE_LAUNCH 1
#endif
constexpr int N_PHASES = 18;
__global__ void __launch_bounds__(NTHR, 2) mega_fwd(Args args) {
    extern __shared__ __attribute__((aligned(16))) unsigned char lds_raw[];
    LAS unsigned char* lds = (LAS unsigned char*)lds_raw;
    cg::grid_group grid = cg::this_grid();
    volatile LAS unsigned* MISC = (volatile LAS unsigned*)(lds + 131072 + 320);
    if (threadIdx.x < 32) MISC[threadIdx.x] = 0u;
    __syncthreads();
    XcdBarrier bar = xcd_barrier_post((unsigned*)(args.ws + WS_BAR), MISC + 8);
    if (args.ph_lo > args.ph_hi) grid.sync();
    const int G = gridDim.x, bid = blockIdx.x;
    unsigned char* ws = args.ws;
    const int lo = args.ph_lo, hi = args.ph_hi;
    const float* NG = args.in[I_NG];
    bf16* XN = (bf16*)(ws + WS_XN); bf16* MIX = (bf16*)(ws + WS_MIX); bf16* HB = (bf16*)(ws + WS_H);
#ifndef PROBE_DBL
#define PROBE_DBL 0
#endif
#define IN(k) (lo <= (k) && (k) < hi)
#define PH(k, ...) if (IN(k)) { __VA_ARGS__ if ((PROBE_DBL >> (k)) & 1) { __VA_ARGS__ } }
#ifndef PROBE_SYNCS
#define PROBE_SYNCS 0
#endif
#define SEAM(k) do { if (IN(k) && IN((k) + 1)) { xcd_barrier(bar); if ((k) == 4) for (int q_ = 0; q_ < PROBE_SYNCS; ++q_) xcd_barrier(bar); } } while (0)
#define GEMM_SPLIT(Aptr, Wptr, NN, KK, E) do { pg8::Gemm g_{(const pg8::bf16_t*)(Aptr), (const pg8::bf16_t*)(Wptr), MPAD, (NN), (KK)}; pg8::StaticOrder S_; S_.init(MPAD, (NN), G, bid); \
        pg8::gemm_phase<pg8::EpiSplit, pg8::StaticOrder, true, true>(lds, g_, S_, E); } while (0)
#define GEMM_N1024(Aptr, Wptr, KK) do { pg8::EpiSplit E_{MIX, DM, DM, nullptr, 0, DM, nullptr, 0, nullptr}; pg8::Gemm g_{(const pg8::bf16_t*)(Aptr), (const pg8::bf16_t*)(Wptr), MPR, DM, (KK)}; pg8::StaticOrder S_; S_.init(MPR, DM, G, bid); \
        pg8::gemm_phase<pg8::EpiSplit, pg8::StaticOrder, true, true>(lds, g_, S_, E_); sample_gemm((const bf16*)(Aptr), (const bf16*)(Wptr), (KK), MIX, lds, bid); } while (0)
#define GEMM_SWIGLU(Aptr, Wptr, E) do { pg8::Gemm g_{(const pg8::bf16_t*)(Aptr), (const pg8::bf16_t*)(Wptr), MPAD, 2 * DFF, DM}; pg8::StaticOrder S_; S_.init(MPAD, 2 * DFF, G, bid); \
        pg8::gemm_phase<pg8::EpiSwiGLU, pg8::StaticOrder, true, true>(lds, g_, S_, E); } while (0)
    PH(0, p0_prologue(args, lds, G, bid);) SEAM(0);
    PH(1, pg8::EpiSplit E{(bf16*)(ws + WS_P0), AB_IN, AB_IN, nullptr, 0, AB_IN, nullptr, 0, nullptr}; GEMM_SPLIT(XN, ws + WS_W_ABIN, AB_IN, DM, E);) SEAM(1);
    PH(2, attn_phase(args, lds, G, bid);) SEAM(2);
    PH(3, GEMM_N1024(ws + WS_CAT, ws + WS_W_ABOUT, DM);) SEAM(3);
    PH(4, nrn_mid<true>(args, NG + 1 * DM, NG + 2 * DM, G, bid);) SEAM(4);
    PH(5, pg8::EpiSwiGLU E{HB, DFF}; GEMM_SWIGLU(XN, ws + WS_W_UP0, E);) SEAM(5);
    PH(6, GEMM_N1024(HB, ws + WS_W_DN0, DFF);) SEAM(6);
    PH(7, nrn_mid<false>(args, NG + 3 * DM, NG + 4 * DM, G, bid);) SEAM(7);
    PH(8, pg8::EpiSplit E{(bf16*)(ws + WS_Z), ZW, ZW, (bf16*)(ws + WS_XBC), XBCW, ZW + XBCW, (float*)(ws + WS_DT), 32, (bf16*)(ws + WS_HALO)}; GEMM_SPLIT(XN, ws + WS_W_SSMIN, SSM_INP, DM, E);) SEAM(8);
    PH(9, ssmconv_phase(args, G, bid);) SEAM(9);
    PH(10, ssd_pass_a(args, lds, G, bid);) SEAM(10);
    PH(11, ssd_pass_b(args, lds, G, bid);) SEAM(11);
    PH(12, gnorm_phase(args, G, bid);) SEAM(12);
    PH(13, GEMM_N1024(ws + WS_Z, ws + WS_W_SSMOUT, ZW);) SEAM(13);
    PH(14, nrn_mid<false>(args, NG + 5 * DM, NG + 6 * DM, G, bid);) SEAM(14);
    PH(15, pg8::EpiSwiGLU E{HB, DFF}; GEMM_SWIGLU(XN, ws + WS_W_UP1, E);) SEAM(15);
    PH(16, GEMM_N1024(HB, ws + WS_W_DN1, DFF);) SEAM(16);
    if (IN(17)) nrn_final(args, NG + 7 * DM, G, bid, bar);
#undef IN
#undef SEAM
}

extern "C" void kernel_launch(void* const* d_in, const int* in_sizes, int n_in, void* d_out, int out_size, void* d_ws, size_t ws_size, hipStream_t stream) {
    static int grid = 0;
    if (grid == 0) {
        if (n_in != 23 || out_size != (int)O_END || ws_size < WS_END) { fprintf(stderr, "kernel_launch: unexpected shapes (n_in %d out %d ws %zu)\n", n_in, out_size, ws_size); grid = -1; return; }
        int dev = 0, cus = 0, per_cu = 0;
        (void)hipGetDevice(&dev); (void)hipDeviceGetAttribute(&cus, hipDeviceAttributeMultiprocessorCount, dev);
        if (hipFuncSetAttribute((const void*)mega_fwd, hipFuncAttributeMaxDynamicSharedMemorySize, LDS_BYTES) != hipSuccess) { fprintf(stderr, "kernel_launch: hipFuncSetAttribute failed\n"); grid = -1; return; }
        if (hipOccupancyMaxActiveBlocksPerMultiprocessor(&per_cu, (const void*)mega_fwd, NTHR, LDS_BYTES) != hipSuccess || per_cu < 1) { fprintf(stderr, "kernel_launch: occupancy query gave %d\n", per_cu); per_cu = 1; }
        (void)hipGetLastError();
        grid = cus * 1;
        if (grid != 256) { fprintf(stderr, "kernel_launch: built for a 256-CU device (got %d)\n", grid); grid = -1; return; }
    }
    if (grid < 0) return;
    Args a{};
    for (int i = 0; i < 23; ++i) a.in[i] = (const float*)d_in[i];
    a.out = (float*)d_out; a.ws = (unsigned char*)d_ws;
    if (hipMemsetAsync((char*)d_ws + WS_BAR, 0, BAR_BYTES, stream) != hipSuccess) { fprintf(stderr, "kernel_launch: memset failed\n"); return; }
#if MK_ONE_LAUNCH
    a.ph_lo = 0; a.ph_hi = N_PHASES;
    void* kargs[] = {&a};
    hipError_t e = hipLaunchCooperativeKernel((const void*)mega_fwd, dim3(grid), dim3(NTHR), kargs, LDS_BYTES, stream);
    if (e != hipSuccess) fprintf(stderr, "kernel_launch: cooperative launch failed: %s (grid %d)\n", hipGetErrorString(e), grid);
#else
    for (int p = 0; p < N_PHASES; ++p) { a.ph_lo = p; a.ph_hi = p + 1; hipLaunchKernelGGL(mega_fwd, dim3(grid), dim3(NTHR), LDS_BYTES, stream, a); }
#endif
}
```
